# Optimizing an MI355X kernel written in HIP

```python
import math
import jax, jax.numpy as jnp
from jax import lax
import numpy as np

D_MODEL = 2048
BATCH = 8
SEQ = 2048
DEPTH = 2

EPS = 1e-6
GRID_W = 64
HEAD_DIM = 128
ATTN_HEADS = D_MODEL // 256
KV_HEADS = max(1, ATTN_HEADS // 4)
ATTN_WIDTH = ATTN_HEADS * HEAD_DIM
KV_WIDTH = KV_HEADS * HEAD_DIM
Q_BLOCK = 128
ROPE_THETA = 10000.0
ROPE_HALF = HEAD_DIM // 2
LRU_WIDTH = D_MODEL // 2
LRU_BLOCKS = 8
LRU_BLOCK = LRU_WIDTH // LRU_BLOCKS
LRU_C = 8.0
CONV_W = 4
CONV_PAD = (2, 1)
EVEN_IN = ATTN_WIDTH + 2 * KV_WIDTH + ATTN_WIDTH + 2 * LRU_WIDTH
EVEN_MIX = ATTN_WIDTH + LRU_WIDTH
MLSTM_HEADS = 8
MLSTM_V_DIM = D_MODEL // MLSTM_HEADS
MLSTM_QK_DIM = MLSTM_V_DIM // 2
MLSTM_WIDTH = MLSTM_HEADS * MLSTM_V_DIM
MLSTM_QK_WIDTH = MLSTM_HEADS * MLSTM_QK_DIM
MLSTM_CHUNK = 128
N_GATE_SETS = 4
ODD_IN = 2 * MLSTM_QK_WIDTH + 3 * MLSTM_WIDTH + N_GATE_SETS * MLSTM_HEADS
N_EVEN = (DEPTH + 1) // 2
N_ODD = DEPTH // 2

kernel_name = 'hybrid_gqa_rglru_mlstm_encoder'


def rmsnorm(x, g):
    xf = x.astype(jnp.float32)
    y = xf * lax.rsqrt(jnp.mean(xf * xf, axis=-1, keepdims=True) + EPS) * g.astype(jnp.float32)
    return y.astype(x.dtype)


def split_at(t, sizes):
    idx = np.cumsum(sizes)[:-1].tolist()
    return jnp.split(t, idx, axis=-1)


def axial_angles(seq_len):
    rows = seq_len // GRID_W
    row = jnp.repeat(jnp.arange(rows), GRID_W).astype(jnp.float32)
    col = jnp.tile(jnp.arange(GRID_W), rows).astype(jnp.float32)
    inv = ROPE_THETA ** (-jnp.arange(0, ROPE_HALF, 2, dtype=jnp.float32) / ROPE_HALF)
    return row[:, None] * inv, col[:, None] * inv


def rotate_half_pairs(x, ang):
    x1, x2 = jnp.split(x, 2, axis=-1)
    c = jnp.cos(ang)[None, :, None, :]
    s = jnp.sin(ang)[None, :, None, :]
    return jnp.concatenate([x1 * c - x2 * s, x1 * s + x2 * c], axis=-1)


def axial_rope(x, ang_row, ang_col):
    xr, xc = jnp.split(x, 2, axis=-1)
    return jnp.concatenate([rotate_half_pairs(xr, ang_row), rotate_half_pairs(xc, ang_col)], axis=-1)


def block_attention(q, k, v):
    B, S, H, D = q.shape
    G = H // KV_HEADS
    nb = S // Q_BLOCK
    qb = q.reshape(B, nb, Q_BLOCK, KV_HEADS, G, D).transpose(1, 0, 3, 4, 2, 5)
    scale = HEAD_DIM ** -0.5

    def one_block(qi):
        s = jnp.einsum('bkgqd,bskd->bkgqs', qi, k) * scale
        p = jax.nn.softmax(s, axis=-1)
        return jnp.einsum('bkgqs,bskd->bkgqd', p, v)

    o = lax.map(one_block, qb)
    return o.transpose(1, 0, 4, 2, 3, 5).reshape(B, S, H * D)


def lru_combine(e1, e2):
    a1, b1 = e1
    a2, b2 = e2
    return a1 * a2, a2 * b1 + b2


def rg_lru(xc, wa, ba, wx, bx, lam, reverse):
    B, S, W = xc.shape
    xb = xc.reshape(B, S, LRU_BLOCKS, LRU_BLOCK)
    r = jax.nn.sigmoid(jnp.einsum('bsnc,ncd->bsnd', xb, wa).reshape(B, S, W) + ba)
    i = jax.nn.sigmoid(jnp.einsum('bsnc,ncd->bsnd', xb, wx).reshape(B, S, W) + bx)
    log_a = LRU_C * r * jax.nn.log_sigmoid(lam)
    a = jnp.exp(log_a)
    u = jnp.sqrt(-jnp.expm1(2.0 * log_a)) * (i * xc)
    _, h = lax.associative_scan(lru_combine, (a, u), reverse=reverse, axis=1)
    return h


def even_layer(h, w_in, w_out, q_gain, k_gain, conv_w, conv_b, wa, ba, wx, bx, lam):
    B, S, _ = h.shape
    f32 = jnp.float32
    proj = h @ w_in
    q, k, v, g_attn, x_lru, g_lru = split_at(
        proj, [ATTN_WIDTH, KV_WIDTH, KV_WIDTH, ATTN_WIDTH, LRU_WIDTH, LRU_WIDTH])
    q = rmsnorm(q.reshape(B, S, ATTN_HEADS, HEAD_DIM).astype(f32), q_gain)
    k = rmsnorm(k.reshape(B, S, KV_HEADS, HEAD_DIM).astype(f32), k_gain)
    v = v.reshape(B, S, KV_HEADS, HEAD_DIM).astype(f32)
    ang_row, ang_col = axial_angles(S)
    q = axial_rope(q, ang_row, ang_col)
    k = axial_rope(k, ang_row, ang_col)
    attn = block_attention(q, k, v)
    xc = lax.conv_general_dilated(
        x_lru, conv_w[:, None, :], window_strides=(1,), padding=[CONV_PAD],
        dimension_numbers=('NWC', 'WIO', 'NWC'), feature_group_count=LRU_WIDTH) + conv_b
    xc = xc.astype(f32)
    y = (rg_lru(xc, wa[0], ba[0], wx[0], bx[0], lam[0], reverse=False)
         + rg_lru(xc, wa[1], ba[1], wx[1], bx[1], lam[1], reverse=True))
    mix = jnp.concatenate([attn * jax.nn.silu(g_attn.astype(f32)),
                           y * jax.nn.silu(g_lru.astype(f32))], axis=-1)
    return mix.astype(h.dtype) @ w_out


def mlstm_chunkwise(q, k, v, ig, lf):
    B, H, S, dk = q.shape
    dv = v.shape[-1]
    L = MLSTM_CHUNK
    nc = S // L

    def to_chunks(t):
        return jnp.moveaxis(t.reshape((B, H, nc, L) + t.shape[3:]), 2, 0)

    mask = jnp.tril(jnp.ones((L, L), dtype=bool))

    def step(carry, inp):
        C, n, m = carry
        qi, ki, vi, ii, fi = inp
        b = jnp.cumsum(fi, axis=-1)
        logd = jnp.where(mask, b[..., :, None] - b[..., None, :] + ii[..., None, :], -jnp.inf)
        m_inter = b + m[..., None]
        m_t = jnp.maximum(m_inter, jnp.max(logd, axis=-1))
        sc = jnp.einsum('bhld,bhsd->bhls', qi, ki) * jnp.exp(logd - m_t[..., None])
        inter = jnp.exp(m_inter - m_t)
        num = jnp.einsum('bhls,bhsv->bhlv', sc, vi) + inter[..., None] * jnp.einsum('bhld,bhvd->bhlv', qi, C)
        den = jnp.sum(sc, axis=-1) + inter * jnp.einsum('bhld,bhd->bhl', qi, n)
        hout = num / jnp.maximum(jnp.abs(den), jnp.exp(-m_t))[..., None]
        b_last = b[..., -1]
        w = b_last[..., None] - b + ii
        m_new = jnp.maximum(b_last + m, jnp.max(w, axis=-1))
        decay = jnp.exp(b_last + m - m_new)
        ws = jnp.exp(w - m_new[..., None])
        C_new = decay[..., None, None] * C + jnp.einsum('bhsv,bhsd->bhvd', vi * ws[..., None], ki)
        n_new = decay[..., None] * n + jnp.einsum('bhs,bhsd->bhd', ws, ki)
        return (C_new, n_new, m_new), hout

    init = (jnp.zeros((B, H, dv, dk), jnp.float32), jnp.zeros((B, H, dk), jnp.float32),
            jnp.zeros((B, H), jnp.float32))
    _, hc = lax.scan(step, init, (to_chunks(q), to_chunks(k), to_chunks(v), to_chunks(ig), to_chunks(lf)))
    return jnp.moveaxis(hc, 0, 2).reshape(B, H, S, dv)


def odd_layer(h, w_in, gate_bias, norm_gain, w_out):
    B, S, _ = h.shape
    f32 = jnp.float32
    proj = h @ w_in
    q, k, v, o, z, gates = split_at(
        proj, [MLSTM_QK_WIDTH, MLSTM_QK_WIDTH, MLSTM_WIDTH, MLSTM_WIDTH, MLSTM_WIDTH, N_GATE_SETS * MLSTM_HEADS])

    def heads(t, d):
        return t.reshape(B, S, MLSTM_HEADS, d).transpose(0, 2, 1, 3).astype(f32)

    q = heads(q, MLSTM_QK_DIM)
    k = heads(k, MLSTM_QK_DIM) * (MLSTM_QK_DIM ** -0.5)
    v = heads(v, MLSTM_V_DIM)
    g = gates.astype(f32).reshape(B, S, N_GATE_SETS, MLSTM_HEADS) + gate_bias.astype(f32)
    i_f, i_b, f_f, f_b = g.transpose(2, 0, 3, 1)
    h_f = mlstm_chunkwise(q, k, v, i_f, jax.nn.log_sigmoid(f_f))
    flip = lambda t: jnp.flip(t, axis=2)
    h_b = flip(mlstm_chunkwise(flip(q), flip(k), flip(v), flip(i_b), flip(jax.nn.log_sigmoid(f_b))))
    hs = (h_f + h_b).transpose(0, 2, 1, 3)
    hs = jax.nn.sigmoid(o.astype(f32)).reshape(B, S, MLSTM_HEADS, MLSTM_V_DIM) * hs
    hs = rmsnorm(hs, norm_gain.reshape(MLSTM_HEADS, MLSTM_V_DIM))
    hs = hs.reshape(B, S, MLSTM_WIDTH) * jax.nn.silu(z.astype(f32))
    return hs.astype(h.dtype) @ w_out


def setup_inputs(seed: int = 0) -> dict:
    key = jax.random.key(seed)
    ks = jax.random.split(key, 24)
    f32 = jnp.float32
    nrm = lambda k, shape, scale: jax.random.normal(k, shape, f32) * scale
    x = nrm(ks[0], (BATCH, SEQ, D_MODEL), 1.0)
    norm_gain = 1.0 + nrm(ks[1], (DEPTH, D_MODEL), 0.05)
    final_gain = 1.0 + nrm(ks[2], (D_MODEL,), 0.05)
    even_w_in = nrm(ks[3], (N_EVEN, D_MODEL, EVEN_IN), D_MODEL ** -0.5)
    even_w_out = nrm(ks[4], (N_EVEN, EVEN_MIX, D_MODEL), EVEN_MIX ** -0.5)
    q_norm_gain = 1.0 + nrm(ks[5], (N_EVEN, HEAD_DIM), 0.05)
    k_norm_gain = 1.0 + nrm(ks[6], (N_EVEN, HEAD_DIM), 0.05)
    conv_w = nrm(ks[7], (N_EVEN, CONV_W, LRU_WIDTH), CONV_W ** -0.5)
    conv_b = nrm(ks[8], (N_EVEN, LRU_WIDTH), 0.02)
    lru_wa = nrm(ks[9], (N_EVEN, 2, LRU_BLOCKS, LRU_BLOCK, LRU_BLOCK), LRU_BLOCK ** -0.5)
    lru_ba = nrm(ks[10], (N_EVEN, 2, LRU_WIDTH), 0.1)
    lru_wx = nrm(ks[11], (N_EVEN, 2, LRU_BLOCKS, LRU_BLOCK, LRU_BLOCK), LRU_BLOCK ** -0.5)
    lru_bx = nrm(ks[12], (N_EVEN, 2, LRU_WIDTH), 0.1)
    a0 = jax.random.uniform(ks[13], (N_EVEN, 2, LRU_WIDTH), f32, minval=0.9, maxval=0.999)
    p = a0 ** (1.0 / LRU_C)
    lru_lambda = jnp.log(p) - jnp.log1p(-p)
    odd_w_in = nrm(ks[14], (N_ODD, D_MODEL, ODD_IN), D_MODEL ** -0.5)
    i_bias = nrm(ks[15], (N_ODD, 2, MLSTM_HEADS), 0.1)
    f_bias = jnp.broadcast_to(jnp.linspace(3.0, 6.0, MLSTM_HEADS, dtype=f32), (N_ODD, 2, MLSTM_HEADS)) \
        + nrm(ks[16], (N_ODD, 2, MLSTM_HEADS), 0.1)
    odd_gate_bias = jnp.concatenate([i_bias, f_bias], axis=1)
    odd_norm_gain = 1.0 + nrm(ks[17], (N_ODD, MLSTM_WIDTH), 0.05)
    odd_w_out = nrm(ks[18], (N_ODD, MLSTM_WIDTH, D_MODEL), MLSTM_WIDTH ** -0.5)
    return {'x': x, 'norm_gain': norm_gain, 'final_gain': final_gain,
            'even_w_in': even_w_in, 'even_w_out': even_w_out,
            'q_norm_gain': q_norm_gain, 'k_norm_gain': k_norm_gain,
            'conv_w': conv_w, 'conv_b': conv_b,
            'lru_wa': lru_wa, 'lru_ba': lru_ba, 'lru_wx': lru_wx, 'lru_bx': lru_bx,
            'lru_lambda': lru_lambda,
            'odd_w_in': odd_w_in, 'odd_gate_bias': odd_gate_bias,
            'odd_norm_gain': odd_norm_gain, 'odd_w_out': odd_w_out}


def reference(x, norm_gain, final_gain, even_w_in, even_w_out, q_norm_gain, k_norm_gain,
              conv_w, conv_b, lru_wa, lru_ba, lru_wx, lru_bx, lru_lambda,
              odd_w_in, odd_gate_bias, odd_norm_gain, odd_w_out):
    for layer in range(DEPTH):
        hn = rmsnorm(x, norm_gain[layer])
        j = layer // 2
        if layer % 2 == 0:
            out = even_layer(hn, even_w_in[j], even_w_out[j], q_norm_gain[j], k_norm_gain[j],
                             conv_w[j], conv_b[j], lru_wa[j], lru_ba[j], lru_wx[j], lru_bx[j],
                             lru_lambda[j])
        else:
            out = odd_layer(hn, odd_w_in[j], odd_gate_bias[j], odd_norm_gain[j], odd_w_out[j])
        x = x + out.astype(x.dtype)
    return rmsnorm(x, final_gain)
```

```cpp
#include <hip/hip_runtime.h>
#include <hip/hip_bf16.h>
#include <hip/hip_cooperative_groups.h>
#include <cstdio>
#include <cstdint>
namespace cg = cooperative_groups;
namespace pg8 {
#define PG8_LAS __attribute__((address_space(3)))
typedef unsigned short bf16_t;
typedef short bf16x8 __attribute__((ext_vector_type(8)));
typedef float f32x4 __attribute__((ext_vector_type(4)));
typedef unsigned u32x4 __attribute__((ext_vector_type(4)));
constexpr int BM = 256, BK = 64, HALF = 128, HTB = HALF * BK * 2  , STAGE_BYTES = 8 * HTB, NXCD = 8, WGM = 8;

__host__ __device__ __forceinline__ int lds_byte(int r, int c) { const int st = (r >> 4) * 2 + (c >> 5), rr = r & 15, cc = c & 31, ob = rr * 64 + cc * 2; return st * 1024 + (ob ^ (((ob >> 9) & 1) << 5)); }
__host__ __device__ __forceinline__ void stage_rc(int b, int& R, int& C) { const int st = b / 1024, sb = b % 1024, swz = sb ^ (((sb >> 9) & 1) << 5); R = (st >> 1) * 16 + swz / 64; C = (st & 1) * 32 + (swz % 64) / 2; }
__host__ __device__ __forceinline__ int perm32(int rho) { const int n = rho >> 4, i = rho & 15; return 8 * (i >> 2) + 4 * n + (i & 3); }

struct Unit { int pm, pn; };
struct Gemm { const bf16_t* A; const bf16_t* Bt; int M, N, K; };

struct StaticOrder {
    int nM, nN, nwg, G, c;
    __host__ __device__ void init(int M, int N, int G_, int c_) { nM = M / BM; nN = N / BM; nwg = nM * nN; G = G_; c = c_; }
    __host__ __device__ bool next(int i, Unit& u) const {
        const long L = (long)i * G + c; if (L >= nwg) return false;
        int wgid = (int)L; { const int q = nwg / NXCD, r = nwg % NXCD, xcd = wgid % NXCD, off = wgid / NXCD; wgid = (xcd < r ? xcd * (q + 1) : r * (q + 1) + (xcd - r) * q) + off; }
        const int nig = WGM * nN, gid = wgid / nig, fm = gid * WGM, gsz = (nM - fm) < WGM ? (nM - fm) : WGM;
        u.pm = fm + ((wgid % nig) % gsz); u.pn = (wgid % nig) / gsz; return true;
    }
    __device__ __forceinline__ void a_ready(const Unit&) const {}
    __device__ __forceinline__ void done(const Unit&) const {}
};
__device__ __forceinline__ unsigned cvt_pk_bf16(float lo, float hi) { unsigned r; asm volatile("v_cvt_pk_bf16_f32 %0, %1, %2" : "=v"(r) : "v"(lo), "v"(hi)); return r; }
#ifndef EPI_WT
#define EPI_WT 0
#endif
__device__ __forceinline__ void st16(void* p, u32x4 v) {
#if EPI_WT == 1
    asm volatile("global_store_dwordx4 %0, %1, off sc1\n\ts_nop 1" :: "v"(p), "v"(v) : "memory");
#elif EPI_WT == 2
    __builtin_nontemporal_store(v, (u32x4*)p);
#else
    *(u32x4*)p = v;
#endif
}
__device__ __forceinline__ void st16f(void* p, f32x4 v) {
#if EPI_WT == 1
    asm volatile("global_store_dwordx4 %0, %1, off sc1\n\ts_nop 1" :: "v"(p), "v"(v) : "memory");
#elif EPI_WT == 2
    __builtin_nontemporal_store(v, (f32x4*)p);
#else
    *(f32x4*)p = v;
#endif
}
__device__ __forceinline__ void st8(void* p, unsigned long long v) {
#if EPI_WT == 1
    asm volatile("global_store_dwordx2 %0, %1, off sc1\n\ts_nop 1" :: "v"(p), "v"(v) : "memory");
#elif EPI_WT == 2
    __builtin_nontemporal_store(v, (unsigned long long*)p);
#else
    *(unsigned long long*)p = v;
#endif
}
struct EpiBf16S {
    static constexpr bool PERM = true, AFTER_DRAIN = false;
    bf16_t* O; int ldc; int s_lo, s_hi; float scale; const float* rowss;
    __device__ __forceinline__ void operator()(const f32x4 (&acc)[2][2][4][2], const Unit& u, int wr, int wc, int fr, int fq) const {
        const int row0 = u.pm * BM + wr * 64 + fr, col0 = u.pn * BM + wc * 32 + 8 * fq;
        const float sc = (u.pn >= s_lo && u.pn < s_hi) ? scale : 1.f;
        float rss[2][4];
#pragma unroll
        for (int ai = 0; ai < 2; ++ai)
#pragma unroll
            for (int m = 0; m < 4; ++m) rss[ai][m] = rowss ? rowss[row0 + ai * HALF + m * 16] : 0.f;
#pragma unroll
        for (int ai = 0; ai < 2; ++ai)
#pragma unroll
            for (int m = 0; m < 4; ++m) { bf16_t* rowp = O + (size_t)(row0 + ai * HALF + m * 16) * ldc + col0;
                const float rsc = rowss ? sc * rsqrtf(rss[ai][m] * (1.f / 2048.f) + 1e-6f) : sc;
#pragma unroll
                for (int bj = 0; bj < 2; ++bj) { const f32x4 v0 = acc[ai][bj][m][0] * rsc, v1 = acc[ai][bj][m][1] * rsc;
                    u32x4 w; w.x = cvt_pk_bf16(v0[0], v0[1]); w.y = cvt_pk_bf16(v0[2], v0[3]); w.z = cvt_pk_bf16(v1[0], v1[1]); w.w = cvt_pk_bf16(v1[2], v1[3]);
                    st16(rowp + bj * HALF, w); } }
    }
};
struct EpiResF32 {
    static constexpr bool PERM = false, AFTER_DRAIN = false;
    const float* res; float* out; int ld;
    __device__ __forceinline__ void operator()(const f32x4 (&acc)[2][2][4][2], const Unit& u, int wr, int wc, int fr, int fq) const {
        const int row0 = u.pm * BM + wr * 64 + fr, col0 = u.pn * BM + wc * 32 + 4 * fq;
#pragma unroll
        for (int ai = 0; ai < 2; ++ai)
#pragma unroll
            for (int m = 0; m < 4; ++m) { const size_t off = (size_t)(row0 + ai * HALF + m * 16) * ld + col0;
#pragma unroll
                for (int bj = 0; bj < 2; ++bj)
#pragma unroll
                    for (int n = 0; n < 2; ++n) { const size_t idx = off + bj * HALF + n * 16; const f32x4 r = *(const f32x4*)(res + idx); st16f(out + idx, r + acc[ai][bj][m][n]); } }
    }
};
struct EpiResNorm {
    static constexpr bool PERM = false, AFTER_DRAIN = false;
    const float* res; float* out; int ld; const float* gain; bf16_t* xn; float* rowss;
    __device__ __forceinline__ void operator()(const f32x4 (&acc)[2][2][4][2], const Unit& u, int wr, int wc, int fr, int fq) const {
        const int row0 = u.pm * BM + wr * 64 + fr, col0 = u.pn * BM + wc * 32 + 4 * fq;
        f32x4 gv[2][2];
#pragma unroll
        for (int bj = 0; bj < 2; ++bj)
#pragma unroll
            for (int n = 0; n < 2; ++n) gv[bj][n] = *(const f32x4*)(gain + col0 + bj * HALF + n * 16);
#pragma unroll
        for (int ai = 0; ai < 2; ++ai) {
            f32x4 rv[4][2][2];
#pragma unroll
            for (int m = 0; m < 4; ++m)
#pragma unroll
                for (int bj = 0; bj < 2; ++bj)
#pragma unroll
                    for (int n = 0; n < 2; ++n) rv[m][bj][n] = *(const f32x4*)(res + (size_t)(row0 + ai * HALF + m * 16) * ld + col0 + bj * HALF + n * 16);
#pragma unroll
            for (int m = 0; m < 4; ++m) { const int row = row0 + ai * HALF + m * 16; const size_t off = (size_t)row * ld + col0; float ss = 0.f;
#pragma unroll
                for (int bj = 0; bj < 2; ++bj)
#pragma unroll
                    for (int n = 0; n < 2; ++n) { const size_t idx = off + bj * HALF + n * 16; const f32x4 r = rv[m][bj][n] + acc[ai][bj][m][n]; if (out) st16f(out + idx, r);
                        ss += (r[0] * r[0] + r[1] * r[1]) + (r[2] * r[2] + r[3] * r[3]);
                        const f32x4 y = r * gv[bj][n]; unsigned long long w = (unsigned long long)cvt_pk_bf16(y[0], y[1]) | ((unsigned long long)cvt_pk_bf16(y[2], y[3]) << 32);
                        st8(xn + idx, w); }
                ss += __shfl_xor(ss, 16); ss += __shfl_xor(ss, 32);
                if (fq == 0) (void)__hip_atomic_fetch_add(rowss + row, ss, __ATOMIC_RELAXED, __HIP_MEMORY_SCOPE_AGENT); } }
    }
};
struct EpiResNormB {
    static constexpr bool PERM = false, AFTER_DRAIN = false;
    bf16_t* xn; int ld; const float* g0; const float* g1; const float* r0inv; float* rowss;
    __device__ __forceinline__ void operator()(const f32x4 (&acc)[2][2][4][2], const Unit& u, int wr, int wc, int fr, int fq) const {
        const int row0 = u.pm * BM + wr * 64 + fr, col0 = u.pn * BM + wc * 32 + 4 * fq;
        f32x4 rg[2][2], gv[2][2];
#pragma unroll
        for (int bj = 0; bj < 2; ++bj)
#pragma unroll
            for (int n = 0; n < 2; ++n) { const f32x4 g = *(const f32x4*)(g0 + col0 + bj * HALF + n * 16); rg[bj][n] = (f32x4){1.f / g[0], 1.f / g[1], 1.f / g[2], 1.f / g[3]};
                gv[bj][n] = *(const f32x4*)(g1 + col0 + bj * HALF + n * 16); }
        float ri[2][4];
#pragma unroll
        for (int ai = 0; ai < 2; ++ai)
#pragma unroll
            for (int m = 0; m < 4; ++m) ri[ai][m] = r0inv[row0 + ai * HALF + m * 16];
#pragma unroll
        for (int ai = 0; ai < 2; ++ai) {
            unsigned long long xv[4][2][2];
#pragma unroll
            for (int m = 0; m < 4; ++m)
#pragma unroll
                for (int bj = 0; bj < 2; ++bj)
#pragma unroll
                    for (int n = 0; n < 2; ++n) xv[m][bj][n] = *(const unsigned long long*)(xn + (size_t)(row0 + ai * HALF + m * 16) * ld + col0 + bj * HALF + n * 16);
#pragma unroll
            for (int m = 0; m < 4; ++m) { const int row = row0 + ai * HALF + m * 16; const size_t off = (size_t)row * ld + col0; float ss = 0.f;
#pragma unroll
                for (int bj = 0; bj < 2; ++bj)
#pragma unroll
                    for (int n = 0; n < 2; ++n) { const size_t idx = off + bj * HALF + n * 16; const unsigned long long w = xv[m][bj][n];
                        const unsigned lo = (unsigned)w, hi = (unsigned)(w >> 32);
                        const f32x4 r = (f32x4){__uint_as_float(lo << 16), __uint_as_float(lo & 0xffff0000u), __uint_as_float(hi << 16), __uint_as_float(hi & 0xffff0000u)} * rg[bj][n] * ri[ai][m] + acc[ai][bj][m][n];
                        ss += (r[0] * r[0] + r[1] * r[1]) + (r[2] * r[2] + r[3] * r[3]);
                        const f32x4 y = r * gv[bj][n];
                        st8(xn + idx, (unsigned long long)cvt_pk_bf16(y[0], y[1]) | ((unsigned long long)cvt_pk_bf16(y[2], y[3]) << 32)); }
                ss += __shfl_xor(ss, 16); ss += __shfl_xor(ss, 32);
                if (fq == 0) (void)__hip_atomic_fetch_add(rowss + row, ss, __ATOMIC_RELAXED, __HIP_MEMORY_SCOPE_AGENT); } }
    }
};
struct EpiResBf16G {
    static constexpr bool PERM = false, AFTER_DRAIN = false;
    bf16_t* xn; int ld; const float* gain; float* rowss;
    __device__ __forceinline__ void operator()(const f32x4 (&acc)[2][2][4][2], const Unit& u, int wr, int wc, int fr, int fq) const {
        const int row0 = u.pm * BM + wr * 64 + fr, col0 = u.pn * BM + wc * 32 + 4 * fq;
        f32x4 rg[2][2];
#pragma unroll
        for (int bj = 0; bj < 2; ++bj)
#pragma unroll
            for (int n = 0; n < 2; ++n) { const f32x4 g = *(const f32x4*)(gain + col0 + bj * HALF + n * 16); rg[bj][n] = (f32x4){1.f / g[0], 1.f / g[1], 1.f / g[2], 1.f / g[3]}; }
#pragma unroll
        for (int ai = 0; ai < 2; ++ai) {
            unsigned long long xv[4][2][2];
#pragma unroll
            for (int m = 0; m < 4; ++m)
#pragma unroll
                for (int bj = 0; bj < 2; ++bj)
#pragma unroll
                    for (int n = 0; n < 2; ++n) xv[m][bj][n] = *(const unsigned long long*)(xn + (size_t)(row0 + ai * HALF + m * 16) * ld + col0 + bj * HALF + n * 16);
#pragma unroll
            for (int m = 0; m < 4; ++m) { const int row = row0 + ai * HALF + m * 16; const size_t off = (size_t)row * ld + col0; float ss = 0.f;
#pragma unroll
                for (int bj = 0; bj < 2; ++bj)
#pragma unroll
                    for (int n = 0; n < 2; ++n) { const size_t idx = off + bj * HALF + n * 16; const unsigned long long w = xv[m][bj][n];
                        const unsigned lo = (unsigned)w, hi = (unsigned)(w >> 32);
                        const f32x4 r = (f32x4){__uint_as_float(lo << 16), __uint_as_float(lo & 0xffff0000u), __uint_as_float(hi << 16), __uint_as_float(hi & 0xffff0000u)} * rg[bj][n] + acc[ai][bj][m][n];
                        ss += (r[0] * r[0] + r[1] * r[1]) + (r[2] * r[2] + r[3] * r[3]);
                        st8(xn + idx, (unsigned long long)cvt_pk_bf16(r[0], r[1]) | ((unsigned long long)cvt_pk_bf16(r[2], r[3]) << 32)); }
                ss += __shfl_xor(ss, 16); ss += __shfl_xor(ss, 32);
                if (fq == 0) (void)__hip_atomic_fetch_add(rowss + row, ss, __ATOMIC_RELAXED, __HIP_MEMORY_SCOPE_AGENT); } }
    }
};
template <class Epi, class Sched, bool ALIGN_EPI = false, bool SP2 = false>
__device__ __forceinline__ void gemm_phase(PG8_LAS unsigned char* lds, const Gemm g, const Sched& S, const Epi& E) {
    const int tid = threadIdx.x, wid = __builtin_amdgcn_readfirstlane(tid >> 6), lane = tid & 63, wr = wid >> 2, wc = wid & 3, fr = lane & 15, fq = lane >> 4;
    const int K = g.K, nt = K / BK;
    unsigned voffA[2], voffB[2];
#pragma unroll
    for (int i = 0; i < 2; ++i) { int R, C; stage_rc(tid * 16 + i * 8192, R, C); const int Rb = Epi::PERM ? ((R & ~31) + perm32(R & 31)) : R;
        voffA[i] = (unsigned)(R * K + C) * 2u; voffB[i] = (unsigned)(Rb * K + C) * 2u; }
    const size_t kstep = (size_t)(BK * 2);
    const size_t hstep = (size_t)HALF * K * 2;
    const size_t tstep = 2 * hstep;
    const unsigned ldsw = (unsigned)wid * 1024u;
    const int aoff = lds_byte(wr * 64 + fr, fq * 8), boff = lds_byte(wc * 32 + fr, fq * 8);
#define PG8_SA(b, h) (((b) * 2 + (h)) * HTB)
#define PG8_SB(b, h) ((4 + (b) * 2 + (h)) * HTB)
#define PG8_STAGE(bufoff, gbase, voff) do { _Pragma("unroll") for (int _i = 0; _i < 2; ++_i) \
        __builtin_amdgcn_global_load_lds((const unsigned*)((const char*)(gbase) + (voff)[_i]), (PG8_LAS unsigned*)(lds + (bufoff) + ldsw + _i * 8192), 16, 0, 0); } while (0)
#define PG8_LDA(dst, b, h) do { _Pragma("unroll") for (int m = 0; m < 4; ++m) _Pragma("unroll") for (int k = 0; k < 2; ++k) dst[m][k] = *(const PG8_LAS bf16x8*)(lds + PG8_SA(b, h) + aoff + m * 2048 + k * 1024); } while (0)
#define PG8_LDB(dst, b, h) do { _Pragma("unroll") for (int n = 0; n < 2; ++n) _Pragma("unroll") for (int k = 0; k < 2; ++k) dst[n][k] = *(const PG8_LAS bf16x8*)(lds + PG8_SB(b, h) + boff + n * 2048 + k * 1024); } while (0)
#define PG8_MMA(ai, bj, At, Bt) do { __builtin_amdgcn_s_setprio(1); _Pragma("unroll") for (int m = 0; m < 4; ++m) _Pragma("unroll") for (int n = 0; n < 2; ++n) _Pragma("unroll") for (int k = 0; k < 2; ++k) \
        acc[ai][bj][m][n] = __builtin_amdgcn_mfma_f32_16x16x32_bf16(Bt[n][k], At[m][k], acc[ai][bj][m][n], 0, 0, 0); __builtin_amdgcn_s_setprio(0); } while (0)
#define PG8_WAIT_V(n) asm volatile("s_waitcnt vmcnt(" #n ")" ::: "memory")
#define PG8_WAIT_L(n) asm volatile("s_waitcnt lgkmcnt(" #n ")" ::: "memory")
#define PG8_BAR __builtin_amdgcn_s_barrier()
#define PG8_SCHED __builtin_amdgcn_sched_barrier(0)
    Unit cur, nxt; int ui = 0;
    if (!S.next(0, cur)) return;
    f32x4 acc[2][2][4][2];
#pragma unroll
    for (int a = 0; a < 2; ++a)
#pragma unroll
        for (int b = 0; b < 2; ++b)
#pragma unroll
            for (int m = 0; m < 4; ++m)
#pragma unroll
                for (int n = 0; n < 2; ++n) acc[a][b][m][n] = (f32x4){0.f, 0.f, 0.f, 0.f};
    bf16x8 At[4][2], B0[2][2], B1[2][2];
    const char* cA = (const char*)g.A + (size_t)cur.pm * tstep; const char* cB = (const char*)g.Bt + (size_t)cur.pn * tstep;
    S.a_ready(cur);
    if constexpr (SP2) {
        PG8_STAGE(PG8_SB(0, 0), cB, voffB); PG8_STAGE(PG8_SB(0, 1), cB + hstep, voffB); PG8_STAGE(PG8_SA(0, 0), cA, voffA); PG8_STAGE(PG8_SA(0, 1), cA + hstep, voffA);
        if (wr == 1) PG8_BAR;
        PG8_WAIT_V(2); PG8_BAR;
        PG8_STAGE(PG8_SB(1, 0), cB + kstep, voffB); PG8_STAGE(PG8_SA(1, 0), cA + kstep, voffA); PG8_STAGE(PG8_SB(1, 1), cB + hstep + kstep, voffB);
        PG8_WAIT_V(6); PG8_BAR;
    } else {
        PG8_STAGE(PG8_SB(0, 0), cB, voffB); PG8_STAGE(PG8_SA(0, 0), cA, voffA); PG8_STAGE(PG8_SB(0, 1), cB + hstep, voffB); PG8_STAGE(PG8_SA(0, 1), cA + hstep, voffA);
        if (wr == 1) PG8_BAR;
        PG8_WAIT_V(4); PG8_BAR;
        PG8_STAGE(PG8_SB(1, 0), cB + kstep, voffB); PG8_STAGE(PG8_SA(1, 0), cA + kstep, voffA); PG8_STAGE(PG8_SB(1, 1), cB + hstep + kstep, voffB);
        PG8_WAIT_V(6); PG8_BAR;
    }
    for (;;) {
        const bool has_next = S.next(ui + 1, nxt);
        const char* nA = has_next ? (const char*)g.A + (size_t)nxt.pm * tstep : cA; const char* nB = has_next ? (const char*)g.Bt + (size_t)nxt.pn * tstep : cB;
        for (int t = 0; t < nt; t += 2) {
            const bool last = (t == nt - 2);
            const char* a1 = cA + (size_t)(t + 1) * kstep;
            const char* a2 = last ? nA : cA + (size_t)(t + 2) * kstep; const char* b2 = last ? nB : cB + (size_t)(t + 2) * kstep;
            const char* a3 = a2 + kstep; const char* b3 = b2 + kstep;
            if (last && has_next) S.a_ready(nxt);
            if constexpr (SP2) {
            PG8_LDB(B0, 0, 0); PG8_LDB(B1, 0, 1); PG8_SCHED; PG8_LDA(At, 0, 0); PG8_STAGE(PG8_SA(1, 1), a1 + hstep, voffA);
            PG8_WAIT_V(8); PG8_WAIT_L(0); PG8_BAR; PG8_MMA(0, 0, At, B0); PG8_MMA(0, 1, At, B1); PG8_BAR; PG8_SCHED;
            PG8_LDA(At, 0, 1); PG8_STAGE(PG8_SB(0, 0), b2, voffB); PG8_STAGE(PG8_SB(0, 1), b2 + hstep, voffB); PG8_STAGE(PG8_SA(0, 0), a2, voffA);
            PG8_WAIT_V(8); PG8_WAIT_L(0); PG8_BAR; PG8_MMA(1, 0, At, B0); PG8_MMA(1, 1, At, B1); PG8_BAR; PG8_SCHED;
            PG8_LDB(B0, 1, 0); PG8_LDB(B1, 1, 1); PG8_SCHED; PG8_LDA(At, 1, 0); PG8_STAGE(PG8_SA(0, 1), a2 + hstep, voffA);
            PG8_WAIT_V(8); PG8_WAIT_L(0); PG8_BAR; PG8_MMA(0, 0, At, B0); PG8_MMA(0, 1, At, B1); PG8_BAR; PG8_SCHED;
            PG8_LDA(At, 1, 1); PG8_STAGE(PG8_SB(1, 0), b3, voffB); PG8_STAGE(PG8_SB(1, 1), b3 + hstep, voffB); PG8_STAGE(PG8_SA(1, 0), a3, voffA);
            PG8_WAIT_V(8); PG8_WAIT_L(0); PG8_BAR; PG8_MMA(1, 0, At, B0); PG8_MMA(1, 1, At, B1); PG8_BAR; PG8_SCHED;
            } else {
            PG8_LDB(B0, 0, 0); PG8_SCHED; PG8_LDA(At, 0, 0); PG8_STAGE(PG8_SA(1, 1), a1 + hstep, voffA);
            PG8_WAIT_L(8); PG8_BAR; PG8_WAIT_L(0); PG8_MMA(0, 0, At, B0); PG8_BAR; PG8_SCHED;
            PG8_LDB(B1, 0, 1); PG8_STAGE(PG8_SB(0, 0), b2, voffB);
            PG8_BAR; PG8_WAIT_L(0); PG8_MMA(0, 1, At, B1); PG8_BAR;
            PG8_LDA(At, 0, 1); PG8_STAGE(PG8_SA(0, 0), a2, voffA);
            PG8_BAR; PG8_WAIT_L(0); PG8_MMA(1, 0, At, B0); PG8_BAR; PG8_SCHED;
            PG8_STAGE(PG8_SB(0, 1), b2 + hstep, voffB);
            PG8_WAIT_V(6); PG8_BAR; PG8_MMA(1, 1, At, B1); PG8_BAR;
            PG8_LDB(B0, 1, 0); PG8_SCHED; PG8_LDA(At, 1, 0); PG8_STAGE(PG8_SA(0, 1), a2 + hstep, voffA);
            PG8_WAIT_L(8); PG8_BAR; PG8_WAIT_L(0); PG8_MMA(0, 0, At, B0); PG8_BAR; PG8_SCHED;
            PG8_LDB(B1, 1, 1); PG8_STAGE(PG8_SB(1, 0), b3, voffB);
            PG8_BAR; PG8_WAIT_L(0); PG8_MMA(0, 1, At, B1); PG8_BAR;
            PG8_LDA(At, 1, 1); PG8_STAGE(PG8_SA(1, 0), a3, voffA);
            PG8_BAR; PG8_WAIT_L(0); PG8_MMA(1, 0, At, B0); PG8_BAR; PG8_SCHED;
            PG8_STAGE(PG8_SB(1, 1), b3 + hstep, voffB);
            PG8_WAIT_V(6); PG8_BAR; PG8_MMA(1, 1, At, B1); PG8_BAR;
            }
        }
        if constexpr (ALIGN_EPI) { if (wr == 0) PG8_BAR; }
        if constexpr (!Epi::AFTER_DRAIN) { E(acc, cur, wr, wc, fr, fq); S.done(cur); }
        if (!has_next) break;
#pragma unroll
        for (int a = 0; a < 2; ++a)
#pragma unroll
            for (int b = 0; b < 2; ++b)
#pragma unroll
                for (int m = 0; m < 4; ++m)
#pragma unroll
                    for (int n = 0; n < 2; ++n) acc[a][b][m][n] = (f32x4){0.f, 0.f, 0.f, 0.f};
        cur = nxt; cA = nA; cB = nB; ++ui;
        if constexpr (ALIGN_EPI) { if (wr == 1) PG8_BAR; }
    }
    PG8_WAIT_V(0);
    if constexpr (!ALIGN_EPI) { if (wr == 0) PG8_BAR; }
    PG8_BAR;
    if constexpr (Epi::AFTER_DRAIN) { E.fused(acc, cur, wr, wc, fr, fq, lds, wid, lane); S.done(cur); }
#undef PG8_SA
#undef PG8_SB
#undef PG8_STAGE
#undef PG8_LDA
#undef PG8_LDB
#undef PG8_MMA
#undef PG8_WAIT_V
#undef PG8_WAIT_L
#undef PG8_BAR
#undef PG8_SCHED
}
}
namespace att {
using bf16 = __hip_bfloat16;
constexpr int   D = 128, NW = 8, QBLK = 32, KVBLK = 64;
constexpr float SCALE = 0.088388347648318440f;
constexpr float THR = 8.f;
constexpr int SDEPTH = 2;
constexpr int LDQ = 4608, LDK = 4608, LDO = 2048, LDG = 4608;
constexpr size_t SHM_V = KVBLK * D * 2, SHM_K = KVBLK * D * 2, SHM_ATTN = 2 * SHM_V + 2 * SHM_K + NW * 64 * 4;
constexpr int OST_OFF = 67584;
using bf16x8 = __attribute__((ext_vector_type(8))) short;
using s16x4  = __attribute__((ext_vector_type(4))) short;
using f32x16 = __attribute__((ext_vector_type(16))) float;
using f32x8  = __attribute__((ext_vector_type(8))) float;
using u32x4  = __attribute__((ext_vector_type(4))) unsigned;
#define KSWZ(row, colB) ((row) * 256 + ((colB) ^ (((row) & 7) << 4)))
#define SBAR() __builtin_amdgcn_sched_barrier(0)
__device__ __forceinline__ int crow(int r, int hi) { return (r & 3) + 8 * (r >> 2) + 4 * hi; }
__device__ __forceinline__ unsigned cvtpk(float lo, float hi) {
  unsigned r; asm volatile("v_cvt_pk_bf16_f32 %0, %1, %2" : "=v"(r) : "v"(lo), "v"(hi)); return r;
}
template <typename TIn> struct Stage;
template <> struct Stage<bf16>  { using T = bf16x8;
  __device__ static __forceinline__ T ld8(const bf16* p) { return *reinterpret_cast<const bf16x8*>(p); }
  __device__ static __forceinline__ bf16x8 tobf(T x) { return x; } };
template <> struct Stage<float> { using T = f32x8;
  __device__ static __forceinline__ T ld8(const float* p) { return *reinterpret_cast<const f32x8*>(p); }
  __device__ static __forceinline__ bf16x8 tobf(T x) {
    u32x4 w = {cvtpk(x[0], x[1]), cvtpk(x[2], x[3]), cvtpk(x[4], x[5]), cvtpk(x[6], x[7])}; return *reinterpret_cast<bf16x8*>(&w); } };

__device__ __forceinline__ void partialSM(f32x16& p0, f32x16& p1, float& m_reg, float& mn, float& alpha) {
  constexpr float C = SCALE * 1.4426950408889634f;
  float pmax = p0[0]; for (int r = 1; r < 16; ++r) pmax = fmaxf(pmax, p0[r]); for (int r = 0; r < 16; ++r) pmax = fmaxf(pmax, p1[r]);
  { auto rr = __builtin_amdgcn_permlane32_swap(__float_as_uint(pmax), __float_as_uint(pmax), false, false);
    pmax = fmaxf(__uint_as_float(rr[0]), __uint_as_float(rr[1])); }
  if (__builtin_expect(__all(pmax - m_reg <= THR / SCALE), 1)) { mn = m_reg; alpha = 1.f; }
  else { mn = fmaxf(m_reg, pmax); alpha = __builtin_amdgcn_exp2f((m_reg - mn) * C); m_reg = mn; }
  float mnC = -mn * C;
  for (int r = 0; r < 16; ++r) p0[r] = fmaf(p0[r], C, mnC); for (int r = 0; r < 16; ++r) p1[r] = fmaf(p1[r], C, mnC);
  for (int r = 0; r < 16; ++r) p0[r] = __builtin_amdgcn_exp2f(p0[r]);
}
__device__ __forceinline__ void finishSM(f32x16& p0, f32x16& p1, float alpha, float& l_reg, bf16x8& pa0, bf16x8& pa1, bf16x8& pa2, bf16x8& pa3) {
  for (int r = 0; r < 16; ++r) p1[r] = __builtin_amdgcn_exp2f(p1[r]);
  float ps = 0; for (int r = 0; r < 16; ++r) ps += p0[r]; for (int r = 0; r < 16; ++r) ps += p1[r];
  { auto rr = __builtin_amdgcn_permlane32_swap(__float_as_uint(ps), __float_as_uint(ps), false, false);
    ps = __uint_as_float(rr[0]) + __uint_as_float(rr[1]); }
  l_reg = l_reg * alpha + ps;
#define PK4(P, BASE, OUT) do { unsigned a0 = cvtpk(P[BASE + 0], P[BASE + 1]), a1 = cvtpk(P[BASE + 2], P[BASE + 3]);   \
    unsigned b0 = cvtpk(P[BASE + 4], P[BASE + 5]), b1 = cvtpk(P[BASE + 6], P[BASE + 7]);                              \
    auto r0 = __builtin_amdgcn_permlane32_swap(a0, b0, false, false); auto r1 = __builtin_amdgcn_permlane32_swap(a1, b1, false, false); \
    u32x4 w = {r0[0], r1[0], r0[1], r1[1]}; OUT = *reinterpret_cast<bf16x8*>(&w); } while (0)
  PK4(p0, 0, pa0); PK4(p0, 8, pa1); PK4(p1, 0, pa2); PK4(p1, 8, pa3);
#undef PK4
}
__device__ __forceinline__ void qkt(f32x16& p0, f32x16& p1, const bf16* Ks, const bf16x8* qr, int r32, int hi) {
  p0 = f32x16{}; p1 = f32x16{};
  for (int d0 = 0; d0 < 8; ++d0) { int cb = (d0 * 16 + hi * 8) * 2;
    bf16x8 b0 = *reinterpret_cast<const bf16x8*>((const char*)Ks + KSWZ(r32, cb));
    bf16x8 b1 = *reinterpret_cast<const bf16x8*>((const char*)Ks + KSWZ(32 + r32, cb));
    p0 = __builtin_amdgcn_mfma_f32_32x32x16_bf16(b0, qr[d0], p0, 0, 0, 0);
    p1 = __builtin_amdgcn_mfma_f32_32x32x16_bf16(b1, qr[d0], p1, 0, 0, 0); }
}
__device__ __forceinline__ int v_st(int k, int c) { const int kk = (k & ~0xC) | ((k & 4) << 1) | ((k & 8) >> 1); return ((kk >> 3) * 4 + (c >> 5)) * 512 + ((kk & 7) * 32 + (c & 31)) * 2; }
__device__ __forceinline__ int v_rd_base(int lane) { return ((lane & 3) << 3) | (((lane >> 2) & 3) << 6) | (((lane >> 4) & 1) << 5) | (((lane >> 5) & 1) << 8); }
constexpr int v_rd_off(int d0, int ks, int half) { return d0 * 512 + ks * 4096 + half * 2048; }
template <int OFF> __device__ __forceinline__ s16x4 tr_read(int vb) {
  s16x4 r; asm volatile("ds_read_b64_tr_b16 %0, %1 offset:%2" : "=&v"(r) : "v"(vb), "i"(OFF) : "memory"); return r;
}
template <int D0> __device__ __forceinline__ void pv_one(f32x16& od, int vb, bf16x8 pa0, bf16x8 pa1, bf16x8 pa2, bf16x8 pa3) {
  const s16x4 l0 = tr_read<v_rd_off(D0, 0, 0)>(vb), h0 = tr_read<v_rd_off(D0, 0, 1)>(vb), l1 = tr_read<v_rd_off(D0, 1, 0)>(vb), h1 = tr_read<v_rd_off(D0, 1, 1)>(vb);
  const s16x4 l2 = tr_read<v_rd_off(D0, 2, 0)>(vb), h2 = tr_read<v_rd_off(D0, 2, 1)>(vb), l3 = tr_read<v_rd_off(D0, 3, 0)>(vb), h3 = tr_read<v_rd_off(D0, 3, 1)>(vb);
  asm volatile("s_waitcnt lgkmcnt(0)" ::: "memory"); SBAR();
#define PK(L, H) (bf16x8){L[0], L[1], L[2], L[3], H[0], H[1], H[2], H[3]}
  od = __builtin_amdgcn_mfma_f32_32x32x16_bf16(pa0, PK(l0, h0), od, 0, 0, 0);
  od = __builtin_amdgcn_mfma_f32_32x32x16_bf16(pa1, PK(l1, h1), od, 0, 0, 0);
  od = __builtin_amdgcn_mfma_f32_32x32x16_bf16(pa2, PK(l2, h2), od, 0, 0, 0);
  od = __builtin_amdgcn_mfma_f32_32x32x16_bf16(pa3, PK(l3, h3), od, 0, 0, 0);
#undef PK
}
__device__ __forceinline__ void pv_d0(f32x16* o, int vb, bf16x8 pa0, bf16x8 pa1, bf16x8 pa2, bf16x8 pa3) {
  pv_one<0>(o[0], vb, pa0, pa1, pa2, pa3); pv_one<1>(o[1], vb, pa0, pa1, pa2, pa3); pv_one<2>(o[2], vb, pa0, pa1, pa2, pa3); pv_one<3>(o[3], vb, pa0, pa1, pa2, pa3);
}

template <typename TQ>
__device__ __forceinline__ void attn_dense_body(const TQ* __restrict__ Qb, const bf16* __restrict__ Kh, const bf16* __restrict__ Vh,
                                                unsigned short* __restrict__ Ob, const unsigned short* __restrict__ Gb, int seq, char* lds) {
  using St = Stage<bf16>; using SQ = Stage<TQ>;
  const int tid = threadIdx.x, wid = tid >> 6, lane = tid & 63, r32 = lane & 31, hi = lane >> 5;
  bf16* V_lds = (bf16*)lds; bf16* K_lds = (bf16*)(lds + 2 * SHM_V);
  float* ws = (float*)(lds + 2 * SHM_V + 2 * SHM_K) + wid * 64; float* li_l = ws; float* al_l = ws + 32;
  float m_reg = -1e30f, l_reg = 0; f32x16 o[4] = {}; bf16x8 qr[8];
  const TQ* Qw = Qb + (long)(wid * QBLK + r32) * LDQ + hi * 8;
#pragma unroll
  for (int d0 = 0; d0 < 8; ++d0) qr[d0] = SQ::tobf(SQ::ld8(Qw + d0 * 16));
  const int sr = tid >> 4, sc = (tid & 15) * 8, vst0 = v_st(sr, sc), vst1 = v_st(32 + sr, sc);
  const int vb0 = (int)(uintptr_t)V_lds + v_rd_base(lane);
  struct { typename St::T vs0, vs1, ks0, ks1; } sr_[SDEPTH];
#define SLOAD(i, k0) do { sr_[i].vs0 = St::ld8(&Vh[(long)((k0) + sr) * LDK + sc]); sr_[i].vs1 = St::ld8(&Vh[(long)((k0) + 32 + sr) * LDK + sc]); \
    sr_[i].ks0 = St::ld8(&Kh[(long)((k0) + sr) * LDK + sc]); sr_[i].ks1 = St::ld8(&Kh[(long)((k0) + 32 + sr) * LDK + sc]); } while (0)
#define SWRITE(b, i) do { *(bf16x8*)((char*)V_lds + (b) * SHM_V + vst0) = St::tobf(sr_[i].vs0);          \
    *(bf16x8*)((char*)V_lds + (b) * SHM_V + vst1) = St::tobf(sr_[i].vs1); int kc = sc * 2;               \
    *(bf16x8*)((char*)K_lds + (b) * SHM_K + KSWZ(sr, kc)) = St::tobf(sr_[i].ks0);                       \
    *(bf16x8*)((char*)K_lds + (b) * SHM_K + KSWZ(32 + sr, kc)) = St::tobf(sr_[i].ks1); } while (0)
#define SWAIT() do { if constexpr (SDEPTH == 2) asm volatile("s_waitcnt vmcnt(4)" ::: "memory"); else asm volatile("s_waitcnt vmcnt(0)" ::: "memory"); } while (0)
#define RESC(a) do { if (__any((a) < 1.f)) { if (hi == 0) al_l[r32] = (a); asm volatile("s_waitcnt lgkmcnt(0)" ::: "memory"); \
    for (int d = 0; d < 4; ++d) for (int r = 0; r < 16; ++r) o[d][r] *= al_l[crow(r, hi)]; } } while (0)
  f32x16 pA0, pA1, pB0, pB1; float mnA, mnB, alA, alB; bf16x8 pa0, pa1, pa2, pa3; const int NT = seq / KVBLK;
  constexpr int SE = 0, SO = SDEPTH - 1;
  SLOAD(SE, 0); asm volatile("s_waitcnt vmcnt(0)" ::: "memory"); SWRITE(0, SE); __syncthreads();
  qkt(pA0, pA1, K_lds, qr, r32, hi); partialSM(pA0, pA1, m_reg, mnA, alA);
  SLOAD(SO, KVBLK); if constexpr (SDEPTH == 2) { if (2 < NT) SLOAD(SE, 2 * KVBLK); }
  SWAIT(); SWRITE(1, SO); __syncthreads();
  for (int j = 1; j + 1 < NT; j += 2) {
    SBAR(); qkt(pB0, pB1, (bf16*)((char*)K_lds + SHM_K), qr, r32, hi);
    finishSM(pA0, pA1, alA, l_reg, pa0, pa1, pa2, pa3); SBAR();
    SLOAD(SO, (j + SDEPTH) * KVBLK); SBAR();
    pv_d0(o, vb0, pa0, pa1, pa2, pa3); partialSM(pB0, pB1, m_reg, mnB, alB);
    __syncthreads(); SWAIT(); SWRITE(0, SE);
    RESC(alB); __syncthreads();
    SBAR(); qkt(pA0, pA1, K_lds, qr, r32, hi);
    finishSM(pB0, pB1, alB, l_reg, pa0, pa1, pa2, pa3); SBAR();
    if (SDEPTH == 1 || j + 3 < NT) SLOAD(SE, (j + 1 + SDEPTH) * KVBLK); SBAR();
    pv_d0(o, vb0 + (int)SHM_V, pa0, pa1, pa2, pa3); partialSM(pA0, pA1, m_reg, mnA, alA);
    __syncthreads(); SWAIT(); SWRITE(1, SO);
    RESC(alA); __syncthreads();
  }
  SBAR(); qkt(pB0, pB1, (bf16*)((char*)K_lds + SHM_K), qr, r32, hi);
  finishSM(pA0, pA1, alA, l_reg, pa0, pa1, pa2, pa3); SBAR();
  pv_d0(o, vb0, pa0, pa1, pa2, pa3); partialSM(pB0, pB1, m_reg, mnB, alB);
  __syncthreads(); RESC(alB);
  finishSM(pB0, pB1, alB, l_reg, pa0, pa1, pa2, pa3); SBAR();
  pv_d0(o, vb0 + (int)SHM_V, pa0, pa1, pa2, pa3);
  if (hi == 0) li_l[r32] = l_reg; asm volatile("s_waitcnt lgkmcnt(0)" ::: "memory");
  float rli[16];
#pragma unroll
  for (int r = 0; r < 16; ++r) rli[r] = __builtin_amdgcn_rcpf(li_l[crow(r, hi)]);
  int lane_e = lane, wide = wid; asm volatile("" : "+v"(lane_e), "+v"(wide));
  char* ost = lds + OST_OFF + wide * (QBLK * 272);
  { char* osw = ost + (4 * (lane_e >> 5)) * 272 + (lane_e & 31) * 2;
#pragma unroll
  for (int r = 0; r < 16; ++r) { const int orow = (r & 3) + 8 * (r >> 2);
#pragma unroll
    for (int d0 = 0; d0 < 4; ++d0) { unsigned uu = __float_as_uint(o[d0][r] * rli[r]); uu = (uu + 0x7fffu + ((uu >> 16) & 1u)) >> 16;
      *(unsigned short*)(osw + orow * 272 + d0 * 64) = (unsigned short)uu; } } }
  asm volatile("s_waitcnt lgkmcnt(0)" ::: "memory");
  const int rowl = lane_e >> 4, ch = lane_e & 15;
  unsigned short* Ow = Ob + (long)(wide * QBLK + rowl) * LDO + ch * 8; const unsigned short* Gw = Gb + (long)(wide * QBLK + rowl) * LDG + ch * 8;
#pragma unroll
  for (int i = 0; i < 8; ++i) { if ((i & 3) == 0) SBAR();
    const u32x4 ov = *reinterpret_cast<const u32x4*>(ost + (rowl + 4 * i) * 272 + ch * 16);
    const u32x4 gv = *reinterpret_cast<const u32x4*>(Gw + (long)(4 * i) * LDG);
    u32x4 res;
#pragma unroll
    for (int e = 0; e < 4; ++e) { const float g0 = __uint_as_float(gv[e] << 16), g1 = __uint_as_float(gv[e] & 0xffff0000u);
      const float o0 = __uint_as_float(ov[e] << 16), o1 = __uint_as_float(ov[e] & 0xffff0000u);
      res[e] = cvtpk(o0 * g0 * __builtin_amdgcn_rcpf(1.f + __expf(-g0)), o1 * g1 * __builtin_amdgcn_rcpf(1.f + __expf(-g1))); }
    *reinterpret_cast<u32x4*>(Ow + (long)(4 * i) * LDO) = res; }
#undef SLOAD
#undef SWRITE
#undef SWAIT
#undef RESC
}
}
#define LAS __attribute__((address_space(3)))
typedef unsigned short u16;
typedef short bf16x8 __attribute__((ext_vector_type(8)));
typedef float f32x4 __attribute__((ext_vector_type(4)));
typedef unsigned u32x4 __attribute__((ext_vector_type(4)));
typedef unsigned u32x2 __attribute__((ext_vector_type(2)));

constexpr int NWAVES = 8;
#ifndef PG8_SP2
#define PG8_SP2 true
#endif
constexpr int BATCH = 8, SEQ = 2048, DM = 2048, M = BATCH * SEQ;
constexpr int EVEN_IN = 4608, ODD_IN = 8224, ODD_MAIN = 8192;
constexpr float EPS = 1e-6f;
constexpr int C_Q = 0, C_K = 1024, C_V = 1280, C_GA = 1536, C_XL = 2560, C_GL = 3584;
constexpr int D_Q = 0, D_K = 1024, D_V = 2048, D_O = 4096, D_Z = 6144;
constexpr int NPHASES = 11;

constexpr size_t MiB = 1u << 20;
constexpr size_t WS_W0T = 0;
constexpr size_t WS_WO0T = 18 * MiB;
constexpr size_t WS_W1T = 26 * MiB;
constexpr size_t WS_WO1T = 58 * MiB;
constexpr size_t WS_WG1T = 66 * MiB;
constexpr size_t WS_LW = 67 * MiB;
constexpr size_t WS_ROPE = 68 * MiB;
constexpr size_t WS_AGG = 69 * MiB;
constexpr size_t WS_GATES = 71 * MiB;
constexpr size_t WS_SUMSQ = 73 * MiB;
constexpr size_t WS_XN = 74 * MiB;
constexpr size_t WS_MIX = 138 * MiB;
constexpr size_t WS_BIG = 202 * MiB;
constexpr size_t WS_HL = WS_BIG + 144 * MiB, WS_PP = WS_HL + 64 * MiB, WS_END = WS_PP + 64 * MiB;

constexpr size_t WS_CTL = 480 * MiB, CTL_BYTES = 16384, WS_TOTAL = WS_CTL + CTL_BYTES;
constexpr int LDS_BYTES = 147456;
constexpr int LDS_MISC = LDS_BYTES - 64;

struct Args { const float* in[18]; float* out; unsigned char* ws; int ph_lo, ph_hi; };

struct Frame {
    LAS unsigned char* lds; char* lds_g;
    int tid, lane, wave, G, gw, NGW;
    const float *x, *norm_gain, *final_gain, *w_in0, *w_out0, *qg, *kg, *conv_w, *conv_b, *lru_wa, *lru_ba, *lru_wx, *lru_bx, *lru_lam, *w_in1, *gate_bias, *norm1, *w_out1;
    float* out;
    unsigned char* ws;
};

__device__ __forceinline__ float bf2f(unsigned b) { return __uint_as_float(b << 16); }
__device__ __forceinline__ unsigned f2bf(float f) { unsigned u = __float_as_uint(f); return (u + 0x7fffu + ((u >> 16) & 1u)) >> 16; }
__device__ __forceinline__ unsigned pk2(float lo, float hi) { return f2bf(lo) | (f2bf(hi) << 16); }
__device__ __forceinline__ float lo16(unsigned w) { return __uint_as_float(w << 16); }
__device__ __forceinline__ float hi16(unsigned w) { return __uint_as_float(w & 0xffff0000u); }
__device__ __forceinline__ float sigmoidf_(float x) { return __builtin_amdgcn_rcpf(1.f + __expf(-x)); }
__device__ __forceinline__ float siluf_(float x) { return x * __builtin_amdgcn_rcpf(1.f + __expf(-x)); }
__device__ __forceinline__ float logsigf_(float x) { return fminf(x, 0.f) - log1pf(__expf(-fabsf(x))); }
__device__ __forceinline__ float wave_sum(float v) {
#pragma unroll
    for (int o = 1; o < 64; o <<= 1) v += __shfl_xor(v, o);
    return v;
}
#define MFMA16(a, b, c) __builtin_amdgcn_mfma_f32_16x16x32_bf16((a), (b), (c), 0, 0, 0)

__device__ __forceinline__ void transpose_item(const float* W, int ldw, int k0, int n0, u16* WT, int ldt, int trow0, LAS float* scr, int lane) {
#pragma unroll
    for (int i = 0; i < 32; ++i) { const int kk = 2 * i + (lane >> 5); scr[kk * 33 + (lane & 31)] = W[(size_t)(k0 + kk) * ldw + n0 + (lane & 31)]; }
    asm volatile("s_waitcnt lgkmcnt(0)" ::: "memory");
    const int c = lane & 7;
#pragma unroll
    for (int j = 0; j < 4; ++j) { const int n = (lane >> 3) + 8 * j; const LAS float* s = scr + (8 * c) * 33 + n;
        u32x4 o; o.x = pk2(s[0 * 33], s[1 * 33]); o.y = pk2(s[2 * 33], s[3 * 33]); o.z = pk2(s[4 * 33], s[5 * 33]); o.w = pk2(s[6 * 33], s[7 * 33]);
        *(u32x4*)(WT + (size_t)(trow0 + n) * ldt + k0 + 8 * c) = o; }
    asm volatile("s_waitcnt lgkmcnt(0)" ::: "memory");
}
__device__ __forceinline__ void rms_row_to_bf16(const float* xrow, const float* gain, u16* orow, int lane, float* rinv) {
    const f32x4* xr = (const f32x4*)xrow + lane; const f32x4* gr = (const f32x4*)gain + lane;
    f32x4 v[8]; float s = 0.f;
#pragma unroll
    for (int j = 0; j < 8; ++j) { v[j] = xr[64 * j]; s += (v[j].x * v[j].x + v[j].y * v[j].y) + (v[j].z * v[j].z + v[j].w * v[j].w); }
    const float ms = wave_sum(s) * (1.f / DM) + EPS; const float r = rsqrtf(ms);
    if (lane == 0) *rinv = sqrtf(ms);
    unsigned long long* o8 = (unsigned long long*)orow + lane;
#pragma unroll
    for (int j = 0; j < 8; ++j) { const f32x4 g = gr[64 * j];
        o8[64 * j] = (unsigned long long)pk2(v[j].x * r * g.x, v[j].y * r * g.y) | ((unsigned long long)pk2(v[j].z * r * g.z, v[j].w * r * g.w) << 32); }
}
__device__ __forceinline__ void w1_item(Frame& F, int r, LAS float* scr) {
    const int kb = r / 257, nb = r % 257;
    if (nb < 256) transpose_item(F.w_in1, ODD_IN, 64 * kb, 32 * nb, ((u16*)(F.ws + WS_W1T)), DM, 32 * nb, scr, F.lane);
    else          transpose_item(F.w_in1, ODD_IN, 64 * kb, ODD_MAIN, ((u16*)(F.ws + WS_WG1T)), DM, 0, scr, F.lane);
}
__device__ __forceinline__ void wo0_item(Frame& F, int r, LAS float* scr) {
    const int kb = r / 64, nb = r % 64; transpose_item(F.w_out0, DM, 64 * kb, 32 * nb, ((u16*)(F.ws + WS_WO0T)), DM, 32 * nb, scr, F.lane);
}
__device__ __forceinline__ void p1_deferred(Frame& F) {
    LAS float* scr = (LAS float*)(F.lds + F.wave * 16384);
    for (int r = ((int)blockIdx.x - 128) * NWAVES + F.wave; r < 32 * 257; r += 128 * NWAVES) w1_item(F, r, scr);
}
__device__ __forceinline__ void p0_prologue(Frame& F) {
    LAS float* scr = (LAS float*)(F.lds + F.wave * 16384);
    constexpr int I0 = 32 * 144, I1 = 32 * 64, I2 = 32 * 257, I3 = 32 * 64, I4 = 256;
    constexpr int NITEMS = I0 + I1 + I2 + I3 + I4;
    for (int it = F.gw; it < NITEMS; it += F.NGW) {
        int r = it;
        if (r < I0) { const int kb = r / 144, nb = r % 144; transpose_item(F.w_in0, EVEN_IN, 64 * kb, 32 * nb, ((u16*)(F.ws + WS_W0T)), DM, 32 * nb, scr, F.lane); continue; } r -= I0;
        if (r < I1) { wo0_item(F, r, scr); continue; } r -= I1;
        if (r < I2) { if (F.G != 256) w1_item(F, r, scr); continue; } r -= I2;
        if (r < I3) { const int kb = r / 64, nb = r % 64; transpose_item(F.w_out1, DM, 64 * kb, 32 * nb, ((u16*)(F.ws + WS_WO1T)), DM, 32 * nb, scr, F.lane); continue; } r -= I3;
        {
            const int blk = r >> 3, sub = r & 7, kb = sub >> 2, nb = sub & 3;
            const int dir = blk >> 4, gate = (blk >> 3) & 1, n = blk & 7;
            const float* src = (gate ? F.lru_wx : F.lru_wa) + (size_t)(dir * 8 + n) * 16384;
            transpose_item(src, 128, 64 * kb, 32 * nb, ((u16*)(F.ws + WS_LW)) + (size_t)((dir * 2 + gate) * 8 + n) * 16384, 128, 32 * nb, scr, F.lane);
        }
    }
    {
        const int g = blockIdx.x * (NWAVES * 64) + F.tid;
        if (g < 64 * 32) { const int pos = g >> 5, i = g & 31;
            const float inv = exp2f(-(float)(2 * i) * (13.287712379549449f / 64.f));
            const float ang = (float)pos * inv;
            ((float*)(F.ws + WS_ROPE))[2 * g] = cosf(ang); ((float*)(F.ws + WS_ROPE))[2 * g + 1] = sinf(ang); }
    }
    for (int i = blockIdx.x * (NWAVES * 64) + F.tid; i < 2 * M; i += F.G * NWAVES * 64) ((float*)(F.ws + WS_SUMSQ))[i] = 0.f;
    for (int m = F.gw; m < M; m += F.NGW) rms_row_to_bf16(F.x + (size_t)m * DM, F.norm_gain, ((u16*)(F.ws + WS_XN)) + (size_t)m * DM, F.lane, ((float*)(F.ws + WS_SUMSQ)) + 3 * M + m);
}

__device__ __forceinline__ void qk_norm_rope(Frame& F) {
    const int half = F.lane >> 5, i = F.lane & 31, colh = i >> 4, j = 2 * (i & 15);
    const int e0 = colh * 64 + j;
    const float* gq = F.qg + e0; const float* gk = F.kg + e0;
    const float q0a = gq[0], q0b = gq[1], q1a = gq[32], q1b = gq[33], k0a = gk[0], k0b = gk[1], k1a = gk[32], k1b = gk[33];
    constexpr int TB = 4;
    for (int tok0 = F.gw; tok0 < M; tok0 += TB * F.NGW) {
        unsigned lo[TB][5], hi[TB][5]; f32x4 cs[TB];
#pragma unroll
        for (int q = 0; q < TB; ++q) { const int tok = tok0 + q * F.NGW; const bool ok = tok < M; const int tk = ok ? tok : tok0;
            const u16* p = ((u16*)(F.ws + WS_BIG)) + (size_t)tk * EVEN_IN + half * 128 + e0;
#pragma unroll
            for (int pp = 0; pp < 5; ++pp) { lo[q][pp] = *(const unsigned*)(p + pp * 256); hi[q][pp] = *(const unsigned*)(p + pp * 256 + 32); }
            const int t = tk & (SEQ - 1), pos = colh ? (t & 63) : (t >> 6);
            cs[q] = *(const f32x4*)(((const float*)(F.ws + WS_ROPE)) + (pos * 32 + j) * 2); }
#pragma unroll
        for (int q = 0; q < TB; ++q) { const int tok = tok0 + q * F.NGW; if (tok < M) {
            u16* p = ((u16*)(F.ws + WS_BIG)) + (size_t)tok * EVEN_IN + half * 128 + e0;
#pragma unroll
            for (int pp = 0; pp < 5; ++pp) {
                float x0a = lo16(lo[q][pp]), x0b = hi16(lo[q][pp]), x1a = lo16(hi[q][pp]), x1b = hi16(hi[q][pp]);
                float ss = (x0a * x0a + x0b * x0b) + (x1a * x1a + x1b * x1b);
#pragma unroll
                for (int o = 1; o < 32; o <<= 1) ss += __shfl_xor(ss, o);
                const float r = rsqrtf(ss * (1.f / 128.f) + EPS);
                x0a *= r * (pp < 4 ? q0a : k0a); x0b *= r * (pp < 4 ? q0b : k0b); x1a *= r * (pp < 4 ? q1a : k1a); x1b *= r * (pp < 4 ? q1b : k1b);
                *(unsigned*)(p + pp * 256) = pg8::cvt_pk_bf16(x0a * cs[q][0] - x1a * cs[q][1], x0b * cs[q][2] - x1b * cs[q][3]);
                *(unsigned*)(p + pp * 256 + 32) = pg8::cvt_pk_bf16(x0a * cs[q][1] + x1a * cs[q][0], x0b * cs[q][3] + x1b * cs[q][2]);
            } } }
    }
}

constexpr int LP = 136;
template <int DIR>
__device__ __forceinline__ void lru_dir(Frame& F, int b, int c, int n, LAS u16* XC, LAS u16* OH, LAS u16* OP) {
    const int wv = F.wave, lane = F.lane, fr = lane & 15, fq = lane >> 4;
    const int dch = n * 128 + 16 * wv + fr;
    bf16x8 Bf[2][4];
#pragma unroll
    for (int g = 0; g < 2; ++g)
#pragma unroll
        for (int kk = 0; kk < 4; ++kk) Bf[g][kk] = *(const bf16x8*)(((u16*)(F.ws + WS_LW)) + ((size_t)((DIR * 2 + g) * 8 + n) * 128 + 16 * wv + fr) * 128 + kk * 32 + fq * 8);
    f32x4 acc[2][8];
#pragma unroll
    for (int m = 0; m < 8; ++m) { acc[0][m] = (f32x4){0.f, 0.f, 0.f, 0.f}; acc[1][m] = (f32x4){0.f, 0.f, 0.f, 0.f}; }
#pragma unroll
    for (int m = 0; m < 8; ++m)
#pragma unroll
        for (int kk = 0; kk < 4; ++kk) { const bf16x8 a = *(const LAS bf16x8*)(XC + (16 * m + fr) * LP + kk * 32 + fq * 8);
            acc[0][m] = MFMA16(a, Bf[0][kk], acc[0][m]); acc[1][m] = MFMA16(a, Bf[1][kk], acc[1][m]); if (kk == 3 && (m & 1)) __builtin_amdgcn_sched_barrier(0); }
    const float ba = F.lru_ba[DIR * 1024 + dch], bx = F.lru_bx[DIR * 1024 + dch], lam = F.lru_lam[DIR * 1024 + dch];
    const float ls8 = 8.f * logsigf_(lam);
#pragma unroll
    for (int m = 0; m < 8; ++m)
#pragma unroll
        for (int j = 0; j < 4; ++j) { const int t = 16 * m + 4 * fq + j;
            const float xc = bf2f(XC[t * LP + 16 * wv + fr]);
            const float r = sigmoidf_(acc[0][m][j] + ba), ig = sigmoidf_(acc[1][m][j] + bx);
            const float la = ls8 * r; const float a = __expf(la);
            const float x2 = 2.f * la;
            const float om = -x2 * (1.f + 0.5f * x2 * (1.f + (1.f / 3.f) * x2 * (1.f + 0.25f * x2 * (1.f + 0.2f * x2))));
            const float u = __builtin_amdgcn_sqrtf(fmaxf(om, 0.f)) * (ig * xc);
            acc[0][m][j] = a; acc[1][m][j] = u; }
    float TP = 1.f, TH = 0.f;
    const int q = DIR ? 3 - fq : fq;
#pragma unroll
    for (int mm = 0; mm < 8; ++mm) { const int m = DIR ? 7 - mm : mm;
        float p[4], h[4];
#pragma unroll
        for (int k = 0; k < 4; ++k) { const int j = DIR ? 3 - k : k;
            if (k == 0) { p[j] = acc[0][m][j]; h[j] = acc[1][m][j]; }
            else { const int jp = DIR ? j + 1 : j - 1; p[j] = p[jp] * acc[0][m][j]; h[j] = acc[0][m][j] * h[jp] + acc[1][m][j]; } }
        const float aggP = p[DIR ? 0 : 3], aggH = h[DIR ? 0 : 3];
        float cP = 1.f, cH = 0.f;
#pragma unroll
        for (int k = 0; k < 3; ++k) { const int sfq = DIR ? 3 - k : k;
            const float qP = __shfl(aggP, fr + 16 * sfq), qH = __shfl(aggH, fr + 16 * sfq);
            if (k < q) { cH = qP * cH + qH; cP = cP * qP; } }
        float tP = cP * aggP, tH = aggP * cH + aggH;
        tP = __shfl(tP, fr + 16 * (DIR ? 0 : 3)); tH = __shfl(tH, fr + 16 * (DIR ? 0 : 3));
        const float prefP = TP * cP, prefH = cP * TH + cH;
#pragma unroll
        for (int j = 0; j < 4; ++j) { const int t = 16 * m + 4 * fq + j;
            OP[t * LP + 16 * wv + fr] = (u16)f2bf(prefP * p[j]);
            OH[t * LP + 16 * wv + fr] = (u16)f2bf(p[j] * prefH + h[j]); }
        TH = tP * TH + tH; TP = TP * tP;
    }
    if (fq == 0) { float* ag = ((float*)(F.ws + WS_AGG)) + ((size_t)((DIR * 8 + b) * 16 + c) * 1024 + dch) * 2; ag[0] = TP; ag[1] = TH; }
    __syncthreads();
    {
        const size_t m0 = (size_t)b * SEQ + c * 128; const int ch = F.tid & 15;
#pragma unroll
        for (int k = 0; k < 4; ++k) { const int row = (F.tid >> 4) + 32 * k;
            const u32x4 vh = *(const LAS u32x4*)(OH + row * LP + ch * 8), vp = *(const LAS u32x4*)(OP + row * LP + ch * 8);
            const size_t gi = ((size_t)DIR * M + m0 + row) * 1024 + n * 128 + ch * 8;
            *(u32x4*)(((u16*)(F.ws + WS_HL)) + gi) = vh; *(u32x4*)(((u16*)(F.ws + WS_PP)) + gi) = vp; }
    }
    __syncthreads();
}
__device__ __forceinline__ void lru_unit(Frame& F, int u) {
    const int b = u >> 7, c = (u >> 3) & 15, n = u & 7;
    LAS u16* XC = (LAS u16*)F.lds; LAS u16* OH = XC + 128 * LP; LAS u16* OP = OH + 128 * LP;
    {
        const int cgp = F.tid & 15, rg = F.tid >> 4, wch = n * 128 + cgp * 8, t0 = c * 128 + rg * 4;
        float cw[4][8], cb[8]; u32x4 xw[7];
#pragma unroll
        for (int j = 0; j < 4; ++j) { const f32x4 a = *(const f32x4*)(F.conv_w + j * 1024 + wch), bq = *(const f32x4*)(F.conv_w + j * 1024 + wch + 4);
            cw[j][0] = a.x; cw[j][1] = a.y; cw[j][2] = a.z; cw[j][3] = a.w; cw[j][4] = bq.x; cw[j][5] = bq.y; cw[j][6] = bq.z; cw[j][7] = bq.w; }
        { const f32x4 a = *(const f32x4*)(F.conv_b + wch), bq = *(const f32x4*)(F.conv_b + wch + 4);
            cb[0] = a.x; cb[1] = a.y; cb[2] = a.z; cb[3] = a.w; cb[4] = bq.x; cb[5] = bq.y; cb[6] = bq.z; cb[7] = bq.w; }
#pragma unroll
        for (int rr = 0; rr < 7; ++rr) { const int t = t0 - 2 + rr;
            xw[rr] = (u32x4){0u, 0u, 0u, 0u};
            if (t >= 0 && t < SEQ) xw[rr] = *(const u32x4*)(((u16*)(F.ws + WS_BIG)) + ((size_t)b * SEQ + t) * EVEN_IN + C_XL + wch); }
#pragma unroll
        for (int r = 0; r < 4; ++r) { float o[8];
#pragma unroll
            for (int e = 0; e < 8; ++e) o[e] = cb[e];
#pragma unroll
            for (int j = 0; j < 4; ++j) { const u32x4 w = xw[r + j];
                o[0] += lo16(w.x) * cw[j][0]; o[1] += hi16(w.x) * cw[j][1]; o[2] += lo16(w.y) * cw[j][2]; o[3] += hi16(w.y) * cw[j][3];
                o[4] += lo16(w.z) * cw[j][4]; o[5] += hi16(w.z) * cw[j][5]; o[6] += lo16(w.w) * cw[j][6]; o[7] += hi16(w.w) * cw[j][7]; }
            u32x4 w; w.x = pk2(o[0], o[1]); w.y = pk2(o[2], o[3]); w.z = pk2(o[4], o[5]); w.w = pk2(o[6], o[7]);
            *(LAS u32x4*)(XC + (rg * 4 + r) * LP + cgp * 8) = w; }
    }
    __syncthreads();
    lru_dir<0>(F, b, c, n, XC, OH, OP);
    lru_dir<1>(F, b, c, n, XC, OH, OP);
}

__device__ __forceinline__ void lru_apply_unit(Frame& F, int u) {
    const int b = u >> 6, c = (u >> 2) & 15, q4 = u & 3, w2 = 2 * F.tid;
    LAS float* CF = (LAS float*)F.lds; LAS float* CB = CF + 1024;
    {
        float cf0 = 0.f, cf1 = 0.f, cb0 = 0.f, cb1 = 0.f;
#pragma unroll 8
        for (int k = 0; k < 16; ++k) { const f32x4 a = *(const f32x4*)(((float*)(F.ws + WS_AGG)) + ((size_t)((0 * 8 + b) * 16 + k) * 1024 + w2) * 2);
            if (k < c) { cf0 = a.x * cf0 + a.y; cf1 = a.z * cf1 + a.w; } }
#pragma unroll 8
        for (int k = 15; k >= 0; --k) { const f32x4 a = *(const f32x4*)(((float*)(F.ws + WS_AGG)) + ((size_t)((1 * 8 + b) * 16 + k) * 1024 + w2) * 2);
            if (k > c) { cb0 = a.x * cb0 + a.y; cb1 = a.z * cb1 + a.w; } }
        CF[w2] = cf0; CF[w2 + 1] = cf1; CB[w2] = cb0; CB[w2 + 1] = cb1;
    }
    __syncthreads();
    {
        const int chg = F.tid & 127, rsub = F.tid >> 7;
        float cf[8], cb[8];
        { const f32x4 a0 = *(const LAS f32x4*)(CF + 8 * chg), a1 = *(const LAS f32x4*)(CF + 8 * chg + 4), b0 = *(const LAS f32x4*)(CB + 8 * chg), b1 = *(const LAS f32x4*)(CB + 8 * chg + 4);
            cf[0] = a0.x; cf[1] = a0.y; cf[2] = a0.z; cf[3] = a0.w; cf[4] = a1.x; cf[5] = a1.y; cf[6] = a1.z; cf[7] = a1.w;
            cb[0] = b0.x; cb[1] = b0.y; cb[2] = b0.z; cb[3] = b0.w; cb[4] = b1.x; cb[5] = b1.y; cb[6] = b1.z; cb[7] = b1.w; }
#pragma unroll 4
        for (int i = 0; i < 8; ++i) { const size_t m = (size_t)b * SEQ + c * 128 + q4 * 32 + rsub + 4 * i; const size_t idx = m * 1024 + 8 * chg;
            const u32x4 hf = *(const u32x4*)(((u16*)(F.ws + WS_HL)) + idx), pf = *(const u32x4*)(((u16*)(F.ws + WS_PP)) + idx);
            const u32x4 hb = *(const u32x4*)(((u16*)(F.ws + WS_HL)) + (size_t)M * 1024 + idx), pb = *(const u32x4*)(((u16*)(F.ws + WS_PP)) + (size_t)M * 1024 + idx);
            const u32x4 gl = *(const u32x4*)(((u16*)(F.ws + WS_BIG)) + m * EVEN_IN + C_GL + 8 * chg);
            u32x4 o;
#pragma unroll
            for (int e = 0; e < 4; ++e) {
                const float y0 = lo16(hf[e]) + lo16(pf[e]) * cf[2 * e] + lo16(hb[e]) + lo16(pb[e]) * cb[2 * e];
                const float y1 = hi16(hf[e]) + hi16(pf[e]) * cf[2 * e + 1] + hi16(hb[e]) + hi16(pb[e]) * cb[2 * e + 1];
                o[e] = pg8::cvt_pk_bf16(y0 * siluf_(lo16(gl[e])), y1 * siluf_(hi16(gl[e]))); }
            *(u32x4*)(((u16*)(F.ws + WS_MIX)) + m * DM + 1024 + 8 * chg) = o; }
    }
    __syncthreads();
}
__device__ __forceinline__ void attn_unit(Frame& F, int u) {
    int b = u >> 6, h = (u >> 3) & 7, qb = u & 7;
    if (F.G == 256) { const int x = blockIdx.x & 7, j = (blockIdx.x >> 3) + 32 * (u >> 8); b = x; h = j >> 3; qb = j & 7; }
    const int kvh = h >> 2;
    const size_t row0 = (size_t)b * SEQ + qb * 256, rowb = (size_t)b * SEQ;
    att::attn_dense_body<att::bf16>((const att::bf16*)(((u16*)(F.ws + WS_BIG)) + row0 * EVEN_IN + C_Q + h * 128), (const att::bf16*)(((u16*)(F.ws + WS_BIG)) + rowb * EVEN_IN + C_K + kvh * 128),
                                    (const att::bf16*)(((u16*)(F.ws + WS_BIG)) + rowb * EVEN_IN + C_V + kvh * 128), ((u16*)(F.ws + WS_MIX)) + row0 * DM + h * 128,
                                    ((u16*)(F.ws + WS_BIG)) + row0 * EVEN_IN + C_GA + h * 128, SEQ, F.lds_g);
    __syncthreads();
}

__device__ __forceinline__ void gates_finish(Frame& F, int r0, f32x4 a0, f32x4 a1) {
    const int fr = F.lane & 15, fq = F.lane >> 4;
    const float bi0 = F.gate_bias[fr], bi1 = F.gate_bias[16 + fr];
#pragma unroll
    for (int j = 0; j < 4; ++j) { float* g = ((float*)(F.ws + WS_GATES)) + (size_t)(r0 + 4 * fq + j) * 32;
        const float rsc = rsqrtf(((const float*)(F.ws + WS_SUMSQ))[r0 + 4 * fq + j] * (1.f / 2048.f) + EPS);
        g[fr] = a0[j] * rsc + bi0; g[16 + fr] = logsigf_(a1[j] * rsc + bi1); }
}
__device__ __forceinline__ void gates_partial(Frame& F, int r0, int kk0, int nkk, f32x4& a0, f32x4& a1) {
    const int lane = F.lane, fr = lane & 15, fq = lane >> 4;
    a0 = (f32x4){0.f, 0.f, 0.f, 0.f}; a1 = a0;
    const u16* ap = ((u16*)(F.ws + WS_XN)) + (size_t)(r0 + fr) * DM + fq * 8 + kk0 * 32; const u16* bp0 = ((u16*)(F.ws + WS_WG1T)) + (size_t)fr * DM + fq * 8 + kk0 * 32; const u16* bp1 = bp0 + 16 * DM;
#pragma unroll 8
    for (int kk = 0; kk < nkk; ++kk) { const bf16x8 a = *(const bf16x8*)(ap + kk * 32);
        a0 = MFMA16(a, *(const bf16x8*)(bp0 + kk * 32), a0); a1 = MFMA16(a, *(const bf16x8*)(bp1 + kk * 32), a1); }
}
__device__ __forceinline__ void gates_task(Frame& F, int task) { f32x4 a0, a1; gates_partial(F, task * 16, 0, 64, a0, a1); gates_finish(F, task * 16, a0, a1); }
constexpr int GWP = 2056;
__device__ __forceinline__ void gates_phase_split(Frame& F) {
    LAS u16* Bs = (LAS u16*)F.lds;
    for (int i = F.tid; i < 32 * 256; i += NWAVES * 64) { const int row = i >> 8, ch = i & 255;
        *(LAS u32x4*)(Bs + row * GWP + ch * 8) = *(const u32x4*)(((u16*)(F.ws + WS_WG1T)) + (size_t)row * DM + ch * 8); }
    __syncthreads();
    const int task = F.gw >> 1, half = F.wave & 1, lane = F.lane, fr = lane & 15, fq = lane >> 4, r0 = task * 16;
    f32x4 a0 = (f32x4){0.f, 0.f, 0.f, 0.f}, a1 = a0;
    const u16* ap = ((u16*)(F.ws + WS_XN)) + (size_t)(r0 + fr) * DM + fq * 8 + half * 1024;
    const LAS u16* bp0 = Bs + fr * GWP + fq * 8 + half * 1024; const LAS u16* bp1 = bp0 + 16 * GWP;
#pragma unroll
    for (int kb = 0; kb < 2; ++kb) { bf16x8 av[16];
#pragma unroll
        for (int kk = 0; kk < 16; ++kk) av[kk] = *(const bf16x8*)(ap + (kb * 16 + kk) * 32);
#pragma unroll
        for (int kk = 0; kk < 16; ++kk) { a0 = MFMA16(av[kk], *(const LAS bf16x8*)(bp0 + (kb * 16 + kk) * 32), a0); a1 = MFMA16(av[kk], *(const LAS bf16x8*)(bp1 + (kb * 16 + kk) * 32), a1); } }
    __syncthreads();
    LAS f32x4* X = (LAS f32x4*)F.lds + (F.wave >> 1) * 128 + lane;
    if (half) { X[0] = a0; X[64] = a1; }
    __syncthreads();
    if (!half) { a0 = a0 + X[0]; a1 = a1 + X[64]; gates_finish(F, r0, a0, a1); }
}

__device__ __forceinline__ void mlstm_unit(Frame& F, int u, u16* Hout) {
    const int b = u >> 5, h = (u >> 2) & 7, dir = (u >> 1) & 1, vh = u & 1;
    const int tid = F.tid, wv = tid >> 6, lane = F.lane, fr = lane & 15, fq = lane >> 4;
    const int rg = wv >> 1, ch = wv & 1;
    LAS u16* Ks = (LAS u16*)F.lds; LAS u16* Ktw = Ks + 128 * LP; LAS u16* Vt = Ktw + 128 * LP; LAS u16* Cb = Vt + 128 * LP;
    LAS float* Gs = (LAS float*)(Cb + 144 * LP); LAS float* MMs = Gs + 128; LAS float* MTs = MMs + 128; LAS float* Ns = MTs + 128; LAS float* SCs = Ns + 128; LAS float* RSs = SCs + 16;
    for (int i = tid; i < 144 * LP / 2; i += NWAVES * 64) ((LAS unsigned*)Cb)[i] = 0u;
    if (tid < 128) Ns[tid] = 0.f;
    f32x4 Cacc[2][4];
#pragma unroll
    for (int mt = 0; mt < 2; ++mt)
#pragma unroll
        for (int nt = 0; nt < 4; ++nt) Cacc[mt][nt] = (f32x4){0.f, 0.f, 0.f, 0.f};
    float mstate = 0.f;
    const u16* P1 = ((u16*)(F.ws + WS_BIG));
#define GROWC(cc, i) ((size_t)b * SEQ + (size_t)(dir ? (SEQ - 1 - (128 * (cc) + (i))) : (128 * (cc) + (i))))
#define GROW(i) GROWC(c, i)
    const int r0 = 2 * lane, r1 = 2 * lane + 1;
    bf16x8 kA[2], kB[2], vA[2], vB[2];
    float gi0 = 0.f, gi1 = 0.f, gf0 = 0.f, gf1 = 0.f;
#define MLOAD(cc) do { const size_t g0_ = GROWC(cc, r0), g1_ = GROWC(cc, r1); \
        _Pragma("unroll") for (int k = 0; k < 2; ++k) { const int col = (wv + 8 * k) * 8; \
            kA[k] = *(const bf16x8*)(P1 + g0_ * ODD_MAIN + D_K + h * 128 + col); kB[k] = *(const bf16x8*)(P1 + g1_ * ODD_MAIN + D_K + h * 128 + col); \
            vA[k] = *(const bf16x8*)(P1 + g0_ * ODD_MAIN + D_V + h * 256 + vh * 128 + col); vB[k] = *(const bf16x8*)(P1 + g1_ * ODD_MAIN + D_V + h * 256 + vh * 128 + col); } \
        if (wv == 0) { const float* G0 = ((float*)(F.ws + WS_GATES)) + g0_ * 32; const float* G1 = ((float*)(F.ws + WS_GATES)) + g1_ * 32; \
            gi0 = G0[dir * 8 + h]; gi1 = G1[dir * 8 + h]; gf0 = G0[16 + dir * 8 + h]; gf1 = G1[16 + dir * 8 + h]; } } while (0)
    MLOAD(0);
    for (int c = 0; c < 16; ++c) {
        bf16x8 Qf[2][4];
#pragma unroll
        for (int mt = 0; mt < 2; ++mt) { const size_t gq_ = GROW(32 * rg + 16 * mt + fr);
#pragma unroll
            for (int kk = 0; kk < 4; ++kk) Qf[mt][kk] = *(const bf16x8*)(P1 + gq_ * ODD_MAIN + D_Q + h * 128 + kk * 32 + fq * 8); }
        if (wv == 0) {
            const float i0 = gi0, i1 = gi1, f0 = gf0, f1 = gf1;
            const float s = f0 + f1; float incl = s;
#pragma unroll
            for (int o = 1; o < 64; o <<= 1) { const float t = __shfl_up(incl, o); if (lane >= o) incl += t; }
            const float b0 = incl - s + f0, b1 = incl;
            const float gg0 = i0 - b0, gg1 = i1 - b1;
            float inclm = fmaxf(gg0, gg1);
#pragma unroll
            for (int o = 1; o < 64; o <<= 1) { const float t = __shfl_up(inclm, o); if (lane >= o) inclm = fmaxf(inclm, t); }
            float exclm = __shfl_up(inclm, 1); if (lane == 0) exclm = -INFINITY;
            const float cm0 = fmaxf(exclm, gg0), cm1 = fmaxf(cm0, gg1);
            const float M0 = fmaxf(mstate, cm0), M1 = fmaxf(mstate, cm1);
            Gs[r0] = gg0; Gs[r1] = gg1; MMs[r0] = M0; MMs[r1] = M1; MTs[r0] = b0 + M0; MTs[r1] = b1 + M1;
            const float blast = __shfl(b1, 63), M127 = __shfl(M1, 63);
            if (lane == 0) { SCs[0] = mstate; SCs[1] = M127; }
            mstate = blast + M127;
        }
        __syncthreads();
        const float mold = SCs[0], M127 = SCs[1];
        const float decay = __expf(mold - M127);
        {   const float ws0 = __expf(Gs[r0] - M127), ws1 = __expf(Gs[r1] - M127);
#pragma unroll
            for (int k = 0; k < 2; ++k) { const int col = (wv + 8 * k) * 8;
                *(LAS bf16x8*)(Ks + r0 * LP + col) = kA[k]; *(LAS bf16x8*)(Ks + r1 * LP + col) = kB[k];
#pragma unroll
                for (int e = 0; e < 8; ++e) {
                    const float ka = bf2f((u16)kA[k][e]) * ws0, kb = bf2f((u16)kB[k][e]) * ws1;
                    ((LAS unsigned*)(Ktw + (col + e) * LP))[lane] = pg8::cvt_pk_bf16(ka, kb);
                    ((LAS unsigned*)(Vt + (col + e) * LP))[lane] = (unsigned)(u16)vA[k][e] | ((unsigned)(u16)vB[k][e] << 16); } }
        }
        { const int cn = c < 15 ? c + 1 : 15; MLOAD(cn); }
        __syncthreads();
        f32x4 S[2][4], N[2][4], N8[2];
#pragma unroll
        for (int mt = 0; mt < 2; ++mt) { N8[mt] = (f32x4){0.f, 0.f, 0.f, 0.f};
#pragma unroll
            for (int nt = 0; nt < 4; ++nt) { S[mt][nt] = (f32x4){0.f, 0.f, 0.f, 0.f}; N[mt][nt] = (f32x4){0.f, 0.f, 0.f, 0.f}; } }
#pragma unroll
        for (int nt = 0; nt < 4; ++nt)
#pragma unroll
            for (int kk = 0; kk < 4; ++kk) {
                const bf16x8 kf = *(const LAS bf16x8*)(Ks + (64 * ch + 16 * nt + fr) * LP + kk * 32 + fq * 8);
                const bf16x8 cf = *(const LAS bf16x8*)(Cb + (64 * ch + 16 * nt + fr) * LP + kk * 32 + fq * 8);
#pragma unroll
                for (int mt = 0; mt < 2; ++mt) { S[mt][nt] = MFMA16(kf, Qf[mt][kk], S[mt][nt]);
                    N[mt][nt] = MFMA16(cf, Qf[mt][kk], N[mt][nt]); } }
#pragma unroll
        for (int kk = 0; kk < 4; ++kk) { const bf16x8 nf = *(const LAS bf16x8*)(Cb + (128 + fr) * LP + kk * 32 + fq * 8);
#pragma unroll
            for (int mt = 0; mt < 2; ++mt) N8[mt] = MFMA16(nf, Qf[mt][kk], N8[mt]); }
        float Ml[2], inter[2], qn[2], rs[2];
#pragma unroll
        for (int mt = 0; mt < 2; ++mt) { const int l = 32 * rg + 16 * mt + fr; Ml[mt] = MMs[l]; inter[mt] = __expf(mold - Ml[mt]); qn[mt] = __shfl(N8[mt][0], fr); rs[mt] = 0.f; }
#pragma unroll
        for (int nt = 0; nt < 4; ++nt) { const f32x4 g4 = *(const LAS f32x4*)(Gs + 64 * ch + 16 * nt + 4 * fq);
#pragma unroll
            for (int mt = 0; mt < 2; ++mt) { const int l = 32 * rg + 16 * mt + fr;
#pragma unroll
                for (int j = 0; j < 4; ++j) { const int sidx = 64 * ch + 16 * nt + 4 * fq + j;
                    const float dm = (sidx <= l) ? __expf(g4[j] - Ml[mt]) : 0.f; const float sc = S[mt][nt][j] * dm; S[mt][nt][j] = sc; rs[mt] += sc; } } }
#pragma unroll
        for (int mt = 0; mt < 2; ++mt) { rs[mt] += __shfl_xor(rs[mt], 16); rs[mt] += __shfl_xor(rs[mt], 32);
            if (fq == 0) RSs[(32 * rg + 16 * mt + fr) * 2 + ch] = rs[mt]; }
        __syncthreads();
#pragma unroll
        for (int mt = 0; mt < 2; ++mt)
#pragma unroll
            for (int nt = 0; nt < 4; ++nt) { u32x2 w; w.x = pg8::cvt_pk_bf16(S[mt][nt][0], S[mt][nt][1]); w.y = pg8::cvt_pk_bf16(S[mt][nt][2], S[mt][nt][3]);
                *(LAS u32x2*)(Ks + (32 * rg + 16 * mt + fr) * LP + 64 * ch + 16 * nt + 4 * fq) = w; }
        __syncthreads();
#pragma unroll
        for (int mt = 0; mt < 2; ++mt)
#pragma unroll
            for (int nt = 0; nt < 4; ++nt) N[mt][nt] = N[mt][nt] * inter[mt];
        {   bf16x8 Af[2][4];
#pragma unroll
            for (int mt = 0; mt < 2; ++mt)
#pragma unroll
                for (int kk = 0; kk < 4; ++kk) Af[mt][kk] = *(const LAS bf16x8*)(Ks + (32 * rg + 16 * mt + fr) * LP + kk * 32 + fq * 8);
#pragma unroll
            for (int nt = 0; nt < 4; ++nt)
#pragma unroll
                for (int kk = 0; kk < 4; ++kk) { const bf16x8 vf = *(const LAS bf16x8*)(Vt + (64 * ch + 16 * nt + fr) * LP + kk * 32 + fq * 8);
#pragma unroll
                    for (int mt = 0; mt < 2; ++mt) N[mt][nt] = MFMA16(vf, Af[mt][kk], N[mt][nt]); }
        }
#pragma unroll
        for (int mt = 0; mt < 2; ++mt) { const int l = 32 * rg + 16 * mt + fr;
            const float den = RSs[2 * l] + RSs[2 * l + 1] + inter[mt] * qn[mt];
            const float inv = __builtin_amdgcn_rcpf(fmaxf(fabsf(den), __expf(-MTs[l])));
            u16* orow = Hout + GROW(l) * DM + h * 256 + vh * 128 + 64 * ch + 4 * fq;
#pragma unroll
            for (int nt = 0; nt < 4; ++nt) { u32x2 w; w.x = pg8::cvt_pk_bf16(N[mt][nt][0] * inv, N[mt][nt][1] * inv); w.y = pg8::cvt_pk_bf16(N[mt][nt][2] * inv, N[mt][nt][3] * inv);
                *(u32x2*)(orow + 16 * nt) = w; } }
#pragma unroll
        for (int mt = 0; mt < 2; ++mt)
#pragma unroll
            for (int nt = 0; nt < 4; ++nt) Cacc[mt][nt] = Cacc[mt][nt] * decay;
        {   bf16x8 Vf[2][4];
#pragma unroll
            for (int mt = 0; mt < 2; ++mt)
#pragma unroll
                for (int kk = 0; kk < 4; ++kk) Vf[mt][kk] = *(const LAS bf16x8*)(Vt + (32 * rg + 16 * mt + fr) * LP + kk * 32 + fq * 8);
#pragma unroll
            for (int nt = 0; nt < 4; ++nt)
#pragma unroll
                for (int kk = 0; kk < 4; ++kk) { const bf16x8 kf = *(const LAS bf16x8*)(Ktw + (64 * ch + 16 * nt + fr) * LP + kk * 32 + fq * 8);
#pragma unroll
                    for (int mt = 0; mt < 2; ++mt) Cacc[mt][nt] = MFMA16(kf, Vf[mt][kk], Cacc[mt][nt]); }
        }
        float nnew = 0.f;
        if (tid < 128) { float sum = 0.f;
#pragma unroll
            for (int s8 = 0; s8 < 16; ++s8) { const u32x4 w = *(const LAS u32x4*)(Ktw + tid * LP + s8 * 8);
                sum += (lo16(w.x) + hi16(w.x)) + (lo16(w.y) + hi16(w.y)) + (lo16(w.z) + hi16(w.z)) + (lo16(w.w) + hi16(w.w)); }
            nnew = decay * Ns[tid] + sum; }
        __syncthreads();
#pragma unroll
        for (int mt = 0; mt < 2; ++mt)
#pragma unroll
            for (int nt = 0; nt < 4; ++nt) { u32x2 w; w.x = pg8::cvt_pk_bf16(Cacc[mt][nt][0], Cacc[mt][nt][1]); w.y = pg8::cvt_pk_bf16(Cacc[mt][nt][2], Cacc[mt][nt][3]);
                *(LAS u32x2*)(Cb + (32 * rg + 16 * mt + fr) * LP + 64 * ch + 16 * nt + 4 * fq) = w; }
        if (tid < 128) { Ns[tid] = nnew; Cb[128 * LP + tid] = (u16)f2bf(nnew); }
    }
#undef GROW
#undef GROWC
#undef MLOAD
    __syncthreads();
}

__device__ __forceinline__ void combine_token(Frame& F, int m, const u16* HF, const u16* HBMIX, u16* DST, size_t didx_mask) {
    const int lane = F.lane, half = lane >> 5, i8 = (lane & 31) * 8;
    const size_t idx = (size_t)m * DM + half * 256 + i8; const u16* pz = ((u16*)(F.ws + WS_BIG)) + (size_t)m * ODD_MAIN + half * 256 + i8;
    u32x4 hf[4], hb[4], ov[4], zv[4];
#pragma unroll
    for (int hp = 0; hp < 4; ++hp) { hf[hp] = *(const u32x4*)(HF + idx + hp * 512); hb[hp] = *(const u32x4*)(HBMIX + idx + hp * 512);
        ov[hp] = *(const u32x4*)(pz + D_O + hp * 512); zv[hp] = *(const u32x4*)(pz + D_Z + hp * 512); }
#pragma unroll
    for (int hp = 0; hp < 4; ++hp) {
        const f32x4 g0 = *(const f32x4*)(F.norm1 + hp * 512 + half * 256 + i8), g1 = *(const f32x4*)(F.norm1 + hp * 512 + half * 256 + i8 + 4);
        float v[8]; float ss = 0.f;
#pragma unroll
        for (int e = 0; e < 4; ++e) { v[2 * e] = sigmoidf_(lo16(ov[hp][e])) * (lo16(hf[hp][e]) + lo16(hb[hp][e])); v[2 * e + 1] = sigmoidf_(hi16(ov[hp][e])) * (hi16(hf[hp][e]) + hi16(hb[hp][e]));
            ss += v[2 * e] * v[2 * e] + v[2 * e + 1] * v[2 * e + 1]; }
#pragma unroll
        for (int o = 1; o < 32; o <<= 1) ss += __shfl_xor(ss, o);
        const float r = rsqrtf(ss * (1.f / 256.f) + EPS);
        u32x4 o;
        o[0] = pg8::cvt_pk_bf16(v[0] * r * g0.x * siluf_(lo16(zv[hp][0])), v[1] * r * g0.y * siluf_(hi16(zv[hp][0])));
        o[1] = pg8::cvt_pk_bf16(v[2] * r * g0.z * siluf_(lo16(zv[hp][1])), v[3] * r * g0.w * siluf_(hi16(zv[hp][1])));
        o[2] = pg8::cvt_pk_bf16(v[4] * r * g1.x * siluf_(lo16(zv[hp][2])), v[5] * r * g1.y * siluf_(hi16(zv[hp][2])));
        o[3] = pg8::cvt_pk_bf16(v[6] * r * g1.z * siluf_(lo16(zv[hp][3])), v[7] * r * g1.w * siluf_(hi16(zv[hp][3])));
        *(u32x4*)(DST + ((idx + hp * 512) & didx_mask)) = o; }
}
__device__ __forceinline__ void final_row(const u16* row, float ss, float* drow, const float* gain, int lane) {
    const unsigned long long* xr = (const unsigned long long*)row + lane; f32x4* dr = (f32x4*)drow + lane; const f32x4* gr = (const f32x4*)gain + lane;
    const float r = rsqrtf(ss * (1.f / DM) + EPS);
    unsigned long long w[8];
#pragma unroll
    for (int j = 0; j < 8; ++j) w[j] = xr[64 * j];
#pragma unroll
    for (int j = 0; j < 8; ++j) { const f32x4 g = gr[64 * j]; const unsigned lo = (unsigned)w[j], hi = (unsigned)(w[j] >> 32);
        dr[64 * j] = (f32x4){lo16(lo) * r * g.x, hi16(lo) * r * g.y, lo16(hi) * r * g.z, hi16(hi) * r * g.w}; }
}

#define XB_TMO      128
#define XB_XCNT(j)  (256  + 64 * (j))
#define XB_XSUB(j)  (1280 + 64 * (j))
#define XB_XGEN(j)  (2304 + 64 * (j))
#define XB_TOP      3328
#define XB_TOPGEN   3392
#define XCD_BAR_WORDS 3456
#define XB_SPIN_CAP (1u << 18)

__device__ __forceinline__ unsigned xb_ld(unsigned* p)              { return __hip_atomic_load(p, __ATOMIC_RELAXED, __HIP_MEMORY_SCOPE_AGENT); }
__device__ __forceinline__ unsigned xb_add(unsigned* p, unsigned v) { return __hip_atomic_fetch_add(p, v, __ATOMIC_RELAXED, __HIP_MEMORY_SCOPE_AGENT); }
__device__ __forceinline__ unsigned xb_xcc_id() { return (unsigned)__builtin_amdgcn_s_getreg((3 << 11) | 20) & 0xFu; }
#define XB_SPIN(cond, bar) do { unsigned _sp = 0; while (cond) { __builtin_amdgcn_s_sleep(1); \
    if ((++_sp & 255u) == 0u) { if (xb_ld(&(bar)[XB_TMO])) break; if (_sp > XB_SPIN_CAP) { atomicAdd(&(bar)[XB_TMO], 1u); break; } } } } while (0)

struct XcdBarrier {
    unsigned* bar; unsigned x;
    volatile LAS unsigned* st;
};

__device__ __forceinline__ XcdBarrier xcd_barrier_post(unsigned* bar, volatile LAS unsigned* st) {
    XcdBarrier b; b.bar = bar; b.x = xb_xcc_id(); b.st = st;
    if (threadIdx.x == 0) (void)xb_add(&bar[XB_XCNT(b.x)], 1u);
    return b;
}
__device__ __forceinline__ void xcd_barrier_complete(unsigned* bar, unsigned x, unsigned& nloc, unsigned& nx) {
    const unsigned G = gridDim.x * gridDim.y * gridDim.z;
    unsigned sum, cnt, mine, sp = 0u;
    for (;;) {
        sum = 0u; cnt = 0u; mine = 0u;
#pragma unroll
        for (unsigned j = 0; j < 16; ++j) { const unsigned c = xb_ld(&bar[XB_XCNT(j)]); sum += c; cnt += (c > 0u) ? 1u : 0u; mine = (j == x) ? c : mine; }
        if (sum == G) break;
        __builtin_amdgcn_s_sleep(1);
        if ((++sp & 255u) == 0u) { if (xb_ld(&bar[XB_TMO])) break; if (sp > XB_SPIN_CAP) { atomicAdd(&bar[XB_TMO], 1u); break; } }
    }
    nloc = mine > 0u ? mine : 1u; nx = cnt > 0u ? cnt : 1u;
}

__device__ __forceinline__ void xcd_barrier(const XcdBarrier& b) {
    asm volatile("s_waitcnt vmcnt(0)" ::: "memory");
    __syncthreads();
    if (threadIdx.x == 0) {
        unsigned* bar = b.bar;
        __builtin_amdgcn_s_waitcnt(0);
        unsigned nloc = b.st[0], nx = b.st[1];
        if (nloc == 0u) { xcd_barrier_complete(bar, b.x, nloc, nx); b.st[0] = nloc; b.st[1] = nx; }
        const unsigned old = xb_add(&bar[XB_XSUB(b.x)], 1u);
        const unsigned gen = old / nloc;
        if (old + 1u == (gen + 1u) * nloc) {
            __builtin_amdgcn_fence(__ATOMIC_RELEASE, "agent");
            asm volatile("s_waitcnt vmcnt(0)" ::: "memory");
            const unsigned og = xb_add(&bar[XB_TOP], 1u);
            const unsigned tg = og / nx;
            if (og + 1u == (tg + 1u) * nx) xb_add(&bar[XB_TOPGEN], 1u);
            else XB_SPIN(xb_ld(&bar[XB_TOPGEN]) == tg, bar);
            __builtin_amdgcn_fence(__ATOMIC_ACQUIRE, "agent");
            xb_add(&bar[XB_XGEN(b.x)], 1u);
            asm volatile("s_waitcnt vmcnt(0)" ::: "memory");
        } else {
            XB_SPIN(xb_ld(&bar[XB_XGEN(b.x)]) == gen, bar);
            __builtin_amdgcn_fence(__ATOMIC_ACQUIRE, "agent");
            asm volatile("s_waitcnt vmcnt(0)" ::: "memory");
        }
    }
    __syncthreads();
}
__global__ void __launch_bounds__(NWAVES * 64, 2) fwd_megakernel(Args args) {
    extern __shared__ __attribute__((aligned(16))) unsigned char lds[];
    cg::grid_group grid = cg::this_grid();
    Frame F;
    F.lds = (LAS unsigned char*)lds; F.lds_g = (char*)lds;
    F.tid = threadIdx.x; F.lane = F.tid & 63; F.wave = __builtin_amdgcn_readfirstlane(F.tid >> 6);
    F.G = gridDim.x; F.gw = blockIdx.x * NWAVES + F.wave; F.NGW = F.G * NWAVES;
    F.x = args.in[0]; F.norm_gain = args.in[1]; F.final_gain = args.in[2]; F.w_in0 = args.in[3]; F.w_out0 = args.in[4]; F.qg = args.in[5]; F.kg = args.in[6];
    F.conv_w = args.in[7]; F.conv_b = args.in[8]; F.lru_wa = args.in[9]; F.lru_ba = args.in[10]; F.lru_wx = args.in[11]; F.lru_bx = args.in[12]; F.lru_lam = args.in[13];
    F.w_in1 = args.in[14]; F.gate_bias = args.in[15]; F.norm1 = args.in[16]; F.w_out1 = args.in[17]; F.out = args.out; F.ws = args.ws;
    const int lo = args.ph_lo, hi = args.ph_hi;
    if (F.tid < 16) ((LAS unsigned*)(F.lds + LDS_MISC))[F.tid] = 0u;
    __syncthreads();
    const XcdBarrier xbar = xcd_barrier_post((unsigned*)(args.ws + WS_CTL), (volatile LAS unsigned*)(F.lds + LDS_MISC));
#ifndef PH_MASK
#define PH_MASK 0x7ff
#endif
#define IN(k) ((((PH_MASK) >> (k)) & 1) && lo <= (k) && (k) < hi)
#ifndef XTRA_XB
#define XTRA_XB 0
#endif
#define SEAM(k) do { if (IN(k) && IN((k) + 1)) { xcd_barrier(xbar); if ((k) == 4) for (int xx_ = 0; xx_ < XTRA_XB; ++xx_) xcd_barrier(xbar); } } while (0)
#ifndef DUP_MASK
#define DUP_MASK 0
#endif
#ifndef EXTRA_SYNCS
#define EXTRA_SYNCS 0
#endif
#define REPS(k) for (int rep_ = 0; rep_ < 1 + (((DUP_MASK) >> (k)) & 1); ++rep_)
#define REPSYNC() do { if (rep_) xcd_barrier(xbar); } while (0)
    for (int es_ = (lo < 0 ? -1 : 0); es_ < EXTRA_SYNCS; ++es_) grid.sync();

    if (IN(0)) REPS(0) { REPSYNC(); p0_prologue(F); __syncthreads(); }
    SEAM(0);
    if (IN(1)) {
        pg8::Gemm g{((u16*)(F.ws + WS_XN)), ((u16*)(F.ws + WS_W0T)), M, EVEN_IN, DM}; pg8::StaticOrder S; S.init(M, EVEN_IN, F.G, (int)blockIdx.x);
        pg8::EpiBf16S E{((u16*)(F.ws + WS_BIG)), EVEN_IN, 0, 0, 1.f, nullptr};
        pg8::gemm_phase<pg8::EpiBf16S, pg8::StaticOrder, true, PG8_SP2>(F.lds, g, S, E);
        if (F.G == 256 && blockIdx.x >= 128) { __syncthreads(); p1_deferred(F); __syncthreads(); }
    }
    SEAM(1);
    if (IN(2)) {
        qk_norm_rope(F);
        for (int u = blockIdx.x; u < 1024; u += F.G) lru_unit(F, u);
    }
    SEAM(2);
    if (IN(3)) {
        REPS(3) { REPSYNC(); for (int u = blockIdx.x; u < 512; u += F.G) attn_unit(F, u); }
        REPS(11) { REPSYNC(); for (int u = blockIdx.x; u < 512; u += F.G) lru_apply_unit(F, u); }
        __syncthreads();
    }
    SEAM(3);
    if (IN(4)) REPS(4) { REPSYNC();
        pg8::Gemm g{((u16*)(F.ws + WS_MIX)), ((u16*)(F.ws + WS_WO0T)), M, DM, DM}; pg8::StaticOrder S; S.init(M, DM, F.G, (int)blockIdx.x);
        pg8::EpiResNormB E{((u16*)(F.ws + WS_XN)), DM, F.norm_gain, F.norm_gain + DM, (const float*)(F.ws + WS_SUMSQ) + 3 * M, (float*)(F.ws + WS_SUMSQ)};
        pg8::gemm_phase<pg8::EpiResNormB, pg8::StaticOrder, true, PG8_SP2>(F.lds, g, S, E);
    }
    SEAM(4);
    if (IN(6) && (((DUP_MASK) >> 12) & 1)) {
        pg8::Gemm g{((u16*)(F.ws + WS_XN)), ((u16*)(F.ws + WS_W1T)), M, ODD_MAIN, DM}; pg8::StaticOrder S; S.init(M, ODD_MAIN, F.G, (int)blockIdx.x);
        pg8::EpiBf16S E{((u16*)(F.ws + WS_BIG)), ODD_MAIN, 4, 8, 0.088388347648318440f, (const float*)(F.ws + WS_SUMSQ)};
        pg8::gemm_phase<pg8::EpiBf16S, pg8::StaticOrder, true, PG8_SP2>(F.lds, g, S, E);
        xcd_barrier(xbar);
    }
    if (IN(4) && (((DUP_MASK) >> 13) & 1)) {
        pg8::Gemm g{((u16*)(F.ws + WS_MIX)), ((u16*)(F.ws + WS_WO0T)), M, DM, DM}; pg8::StaticOrder S; S.init(M, DM, F.G, (int)blockIdx.x);
        pg8::EpiResNorm E{F.x, nullptr, DM, F.norm_gain + DM, ((u16*)(F.ws + WS_XN)), (float*)(F.ws + WS_SUMSQ) + 2 * M};
        pg8::gemm_phase<pg8::EpiResNorm, pg8::StaticOrder, true, PG8_SP2>(F.lds, g, S, E);
        xcd_barrier(xbar);
    }
    if (IN(6)) REPS(6) { REPSYNC();
        if (F.G == 256) gates_phase_split(F); else for (int t = F.gw; t < M / 16; t += F.NGW) gates_task(F, t);
        __syncthreads();
        pg8::Gemm g{((u16*)(F.ws + WS_XN)), ((u16*)(F.ws + WS_W1T)), M, ODD_MAIN, DM}; pg8::StaticOrder S; S.init(M, ODD_MAIN, F.G, (int)blockIdx.x);
        pg8::EpiBf16S E{((u16*)(F.ws + WS_BIG)), ODD_MAIN, 4, 8, 0.088388347648318440f, (const float*)(F.ws + WS_SUMSQ)};
        pg8::gemm_phase<pg8::EpiBf16S, pg8::StaticOrder, true, PG8_SP2>(F.lds, g, S, E);
    }
    SEAM(6);
    if (IN(7)) REPS(7) { REPSYNC(); for (int u = blockIdx.x; u < 256; u += F.G) { const int dir = (u >> 1) & 1; mlstm_unit(F, u, dir ? ((u16*)(F.ws + WS_MIX)) : (u16*)F.out); } }
    SEAM(7);
    if (IN(8) && ((DUP_MASK) >> 8) & 1) { for (int m = F.gw; m < M; m += F.NGW) combine_token(F, m, (const u16*)F.out, ((u16*)(F.ws + WS_MIX)), ((u16*)(F.ws + WS_W0T)), (size_t)(16 * MiB - 1)); xcd_barrier(xbar); }
    if (IN(8)) { for (int m = F.gw; m < M; m += F.NGW) combine_token(F, m, (const u16*)F.out, ((u16*)(F.ws + WS_MIX)), ((u16*)(F.ws + WS_MIX)), ~(size_t)0); }
    SEAM(8);
    if (IN(9)) {
        pg8::Gemm g{((u16*)(F.ws + WS_MIX)), ((u16*)(F.ws + WS_WO1T)), M, DM, DM}; pg8::StaticOrder S; S.init(M, DM, F.G, (int)blockIdx.x);
        pg8::EpiResBf16G E{((u16*)(F.ws + WS_XN)), DM, F.norm_gain + DM, (float*)(F.ws + WS_SUMSQ) + M};
        pg8::gemm_phase<pg8::EpiResBf16G, pg8::StaticOrder, true, PG8_SP2>(F.lds, g, S, E);
    }
    SEAM(9);
    if (IN(10) && ((DUP_MASK) >> 10) & 1) { for (int m = F.gw; m < M; m += F.NGW) final_row(((u16*)(F.ws + WS_XN)) + (size_t)m * DM, ((const float*)(F.ws + WS_SUMSQ))[M + m], ((float*)(F.ws + WS_BIG)) + (size_t)m * DM, F.final_gain, F.lane); xcd_barrier(xbar); }
    if (IN(10)) { for (int m = F.gw; m < M; m += F.NGW) final_row(((u16*)(F.ws + WS_XN)) + (size_t)m * DM, ((const float*)(F.ws + WS_SUMSQ))[M + m], F.out + (size_t)m * DM, F.final_gain, F.lane); }
#undef IN
#undef SEAM
}

#ifndef MK_PER_PHASE
#define MK_PER_PHASE 0
#endif
extern "C" void kernel_launch(void* const* d_in, const int* in_sizes, int n_in, void* d_out, int out_size, void* d_ws, size_t ws_size, hipStream_t stream) {
    static int grid = 0;
    if (grid == 0) {
        if (n_in != 18 || in_sizes[0] != M * DM || out_size != M * DM || ws_size < WS_TOTAL) {
            fprintf(stderr, "kernel_launch: unexpected shapes: n_in %d in0 %d out %d ws %zu (need %zu)\n", n_in, n_in > 0 ? in_sizes[0] : -1, out_size, ws_size, (size_t)WS_TOTAL); grid = -1; return; }
        int dev = 0, cus = 0, per_cu = 0;
        if (hipGetDevice(&dev) != hipSuccess || hipDeviceGetAttribute(&cus, hipDeviceAttributeMultiprocessorCount, dev) != hipSuccess) { grid = -1; return; }
        if (hipFuncSetAttribute((const void*)fwd_megakernel, hipFuncAttributeMaxDynamicSharedMemorySize, LDS_BYTES) != hipSuccess) { fprintf(stderr, "kernel_launch: hipFuncSetAttribute failed\n"); grid = -1; return; }
        if (hipOccupancyMaxActiveBlocksPerMultiprocessor(&per_cu, (const void*)fwd_megakernel, NWAVES * 64, LDS_BYTES) != hipSuccess || per_cu < 1) { fprintf(stderr, "kernel_launch: occupancy query failed (%d)\n", per_cu); grid = -1; return; }
        grid = cus * per_cu;
    }
    if (grid < 0) return;
    if (hipMemsetAsync((char*)d_ws + WS_CTL, 0, CTL_BYTES, stream) != hipSuccess) { fprintf(stderr, "kernel_launch: memset failed\n"); return; }
    Args a{};
    for (int i = 0; i < 18; ++i) a.in[i] = (const float*)d_in[i];
    a.out = (float*)d_out; a.ws = (unsigned char*)d_ws;
#if MK_PER_PHASE
    for (int p = 0; p < NPHASES; ++p) { a.ph_lo = p; a.ph_hi = p + 1; void* kargs[] = {&a};
        hipError_t e = hipLaunchCooperativeKernel((void*)fwd_megakernel, dim3(grid), dim3(NWAVES * 64), kargs, LDS_BYTES, stream);
        if (e != hipSuccess) { fprintf(stderr, "kernel_launch: cooperative launch (phase %d) failed: %s (grid %d)\n", p, hipGetErrorString(e), grid); break; } }
#else
    a.ph_lo = 0; a.ph_hi = NPHASES; void* kargs[] = {&a};
    hipError_t e = hipLaunchCooperativeKernel((void*)fwd_megakernel, dim3(grid), dim3(NWAVES * 64), kargs, LDS_BYTES, stream);
    if (e != hipSuccess) fprintf(stderr, "kernel_launch: cooperative launch failed: %s (grid %d)\n", hipGetErrorString(e), grid);
#endif
}
```

```cpp
#include <hip/hip_runtime.h>
#include <hip/hip_bf16.h>
#include <hip/hip_cooperative_groups.h>
#include <cstdio>
#include <cstdint>
namespace cg = cooperative_groups;
namespace pg8 {
#define PG8_LAS __attribute__((address_space(3)))
typedef unsigned short bf16_t;
typedef short bf16x8 __attribute__((ext_vector_type(8)));
typedef float f32x4 __attribute__((ext_vector_type(4)));
typedef unsigned u32x4 __attribute__((ext_vector_type(4)));
constexpr int BM = 256, BK = 64, HALF = 128, HTB = HALF * BK * 2  , STAGE_BYTES = 8 * HTB, NXCD = 8, WGM = 8;

__host__ __device__ __forceinline__ int lds_byte(int r, int c) { const int st = (r >> 4) * 2 + (c >> 5), rr = r & 15, cc = c & 31, ob = rr * 64 + cc * 2; return st * 1024 + (ob ^ (((ob >> 9) & 1) << 5)); }
__host__ __device__ __forceinline__ void stage_rc(int b, int& R, int& C) { const int st = b / 1024, sb = b % 1024, swz = sb ^ (((sb >> 9) & 1) << 5); R = (st >> 1) * 16 + swz / 64; C = (st & 1) * 32 + (swz % 64) / 2; }
__host__ __device__ __forceinline__ int perm32(int rho) { const int n = rho >> 4, i = rho & 15; return 8 * (i >> 2) + 4 * n + (i & 3); }

struct Unit { int pm, pn; };
struct Gemm { const bf16_t* A; const bf16_t* Bt; int M, N, K; };

struct StaticOrder {
    int nM, nN, nwg, G, c;
    __host__ __device__ void init(int M, int N, int G_, int c_) { nM = M / BM; nN = N / BM; nwg = nM * nN; G = G_; c = c_; }
    __host__ __device__ bool next(int i, Unit& u) const {
        const long L = (long)i * G + c; if (L >= nwg) return false;
        int wgid = (int)L; { const int q = nwg / NXCD, r = nwg % NXCD, xcd = wgid % NXCD, off = wgid / NXCD; wgid = (xcd < r ? xcd * (q + 1) : r * (q + 1) + (xcd - r) * q) + off; }
        const int nig = WGM * nN, gid = wgid / nig, fm = gid * WGM, gsz = (nM - fm) < WGM ? (nM - fm) : WGM;
        u.pm = fm + ((wgid % nig) % gsz); u.pn = (wgid % nig) / gsz; return true;
    }
    __device__ __forceinline__ void a_ready(const Unit&) const {}
    __device__ __forceinline__ void done(const Unit&) const {}
};
__device__ __forceinline__ unsigned cvt_pk_bf16(float lo, float hi) { unsigned r; asm volatile("v_cvt_pk_bf16_f32 %0, %1, %2" : "=v"(r) : "v"(lo), "v"(hi)); return r; }
#ifndef EPI_WT
#define EPI_WT 0
#endif
__device__ __forceinline__ void st16(void* p, u32x4 v) {
#if EPI_WT == 1
    asm volatile("global_store_dwordx4 %0, %1, off sc1\n\ts_nop 1" :: "v"(p), "v"(v) : "memory");
#elif EPI_WT == 2
    __builtin_nontemporal_store(v, (u32x4*)p);
#else
    *(u32x4*)p = v;
#endif
}
__device__ __forceinline__ void st16f(void* p, f32x4 v) {
#if EPI_WT == 1
    asm volatile("global_store_dwordx4 %0, %1, off sc1\n\ts_nop 1" :: "v"(p), "v"(v) : "memory");
#elif EPI_WT == 2
    __builtin_nontemporal_store(v, (f32x4*)p);
#else
    *(f32x4*)p = v;
#endif
}
__device__ __forceinline__ void st8(void* p, unsigned long long v) {
#if EPI_WT == 1
    asm volatile("global_store_dwordx2 %0, %1, off sc1\n\ts_nop 1" :: "v"(p), "v"(v) : "memory");
#elif EPI_WT == 2
    __builtin_nontemporal_store(v, (unsigned long long*)p);
#else
    *(unsigned long long*)p = v;
#endif
}
struct EpiBf16S {
    static constexpr bool PERM = true, AFTER_DRAIN = false;
    bf16_t* O; int ldc; int s_lo, s_hi; float scale; const float* rowss;
    __device__ __forceinline__ void operator()(const f32x4 (&acc)[2][2][4][2], const Unit& u, int wr, int wc, int fr, int fq) const {
        const int row0 = u.pm * BM + wr * 64 + fr, col0 = u.pn * BM + wc * 32 + 8 * fq;
        const float sc = (u.pn >= s_lo && u.pn < s_hi) ? scale : 1.f;
        float rss[2][4];
#pragma unroll
        for (int ai = 0; ai < 2; ++ai)
#pragma unroll
            for (int m = 0; m < 4; ++m) rss[ai][m] = rowss ? rowss[row0 + ai * HALF + m * 16] : 0.f;
#pragma unroll
        for (int ai = 0; ai < 2; ++ai)
#pragma unroll
            for (int m = 0; m < 4; ++m) { bf16_t* rowp = O + (size_t)(row0 + ai * HALF + m * 16) * ldc + col0;
                const float rsc = rowss ? sc * rsqrtf(rss[ai][m] * (1.f / 2048.f) + 1e-6f) : sc;
#pragma unroll
                for (int bj = 0; bj < 2; ++bj) { const f32x4 v0 = acc[ai][bj][m][0] * rsc, v1 = acc[ai][bj][m][1] * rsc;
                    u32x4 w; w.x = cvt_pk_bf16(v0[0], v0[1]); w.y = cvt_pk_bf16(v0[2], v0[3]); w.z = cvt_pk_bf16(v1[0], v1[1]); w.w = cvt_pk_bf16(v1[2], v1[3]);
                    st16(rowp + bj * HALF, w); } }
    }
};
struct EpiResF32 {
    static constexpr bool PERM = false, AFTER_DRAIN = false;
    const float* res; float* out; int ld;
    __device__ __forceinline__ void operator()(const f32x4 (&acc)[2][2][4][2], const Unit& u, int wr, int wc, int fr, int fq) const {
        const int row0 = u.pm * BM + wr * 64 + fr, col0 = u.pn * BM + wc * 32 + 4 * fq;
#pragma unroll
        for (int ai = 0; ai < 2; ++ai)
#pragma unroll
            for (int m = 0; m < 4; ++m) { const size_t off = (size_t)(row0 + ai * HALF + m * 16) * ld + col0;
#pragma unroll
                for (int bj = 0; bj < 2; ++bj)
#pragma unroll
                    for (int n = 0; n < 2; ++n) { const size_t idx = off + bj * HALF + n * 16; const f32x4 r = *(const f32x4*)(res + idx); st16f(out + idx, r + acc[ai][bj][m][n]); } }
    }
};
struct EpiResNorm {
    static constexpr bool PERM = false, AFTER_DRAIN = false;
    const float* res; float* out; int ld; const float* gain; bf16_t* xn; float* rowss;
    __device__ __forceinline__ void operator()(const f32x4 (&acc)[2][2][4][2], const Unit& u, int wr, int wc, int fr, int fq) const {
        const int row0 = u.pm * BM + wr * 64 + fr, col0 = u.pn * BM + wc * 32 + 4 * fq;
        f32x4 gv[2][2];
#pragma unroll
        for (int bj = 0; bj < 2; ++bj)
#pragma unroll
            for (int n = 0; n < 2; ++n) gv[bj][n] = *(const f32x4*)(gain + col0 + bj * HALF + n * 16);
#pragma unroll
        for (int ai = 0; ai < 2; ++ai) {
            f32x4 rv[4][2][2];
#pragma unroll
            for (int m = 0; m < 4; ++m)
#pragma unroll
                for (int bj = 0; bj < 2; ++bj)
#pragma unroll
                    for (int n = 0; n < 2; ++n) rv[m][bj][n] = *(const f32x4*)(res + (size_t)(row0 + ai * HALF + m * 16) * ld + col0 + bj * HALF + n * 16);
#pragma unroll
            for (int m = 0; m < 4; ++m) { const int row = row0 + ai * HALF + m * 16; const size_t off = (size_t)row * ld + col0; float ss = 0.f;
#pragma unroll
                for (int bj = 0; bj < 2; ++bj)
#pragma unroll
                    for (int n = 0; n < 2; ++n) { const size_t idx = off + bj * HALF + n * 16; const f32x4 r = rv[m][bj][n] + acc[ai][bj][m][n]; if (out) st16f(out + idx, r);
                        ss += (r[0] * r[0] + r[1] * r[1]) + (r[2] * r[2] + r[3] * r[3]);
                        const f32x4 y = r * gv[bj][n]; unsigned long long w = (unsigned long long)cvt_pk_bf16(y[0], y[1]) | ((unsigned long long)cvt_pk_bf16(y[2], y[3]) << 32);
                        st8(xn + idx, w); }
                ss += __shfl_xor(ss, 16); ss += __shfl_xor(ss, 32);
                if (fq == 0) (void)__hip_atomic_fetch_add(rowss + row, ss, __ATOMIC_RELAXED, __HIP_MEMORY_SCOPE_AGENT); } }
    }
};
struct EpiResNormB {
    static constexpr bool PERM = false, AFTER_DRAIN = false;
    bf16_t* xn; int ld; const float* g0; const float* g1; const float* r0inv; float* rowss;
    __device__ __forceinline__ void operator()(const f32x4 (&acc)[2][2][4][2], const Unit& u, int wr, int wc, int fr, int fq) const {
        const int row0 = u.pm * BM + wr * 64 + fr, col0 = u.pn * BM + wc * 32 + 4 * fq;
        f32x4 rg[2][2], gv[2][2];
#pragma unroll
        for (int bj = 0; bj < 2; ++bj)
#pragma unroll
            for (int n = 0; n < 2; ++n) { const f32x4 g = *(const f32x4*)(g0 + col0 + bj * HALF + n * 16); rg[bj][n] = (f32x4){1.f / g[0], 1.f / g[1], 1.f / g[2], 1.f / g[3]};
                gv[bj][n] = *(const f32x4*)(g1 + col0 + bj * HALF + n * 16); }
        float ri[2][4];
#pragma unroll
        for (int ai = 0; ai < 2; ++ai)
#pragma unroll
            for (int m = 0; m < 4; ++m) ri[ai][m] = r0inv[row0 + ai * HALF + m * 16];
#pragma unroll
        for (int ai = 0; ai < 2; ++ai) {
            unsigned long long xv[4][2][2];
#pragma unroll
            for (int m = 0; m < 4; ++m)
#pragma unroll
                for (int bj = 0; bj < 2; ++bj)
#pragma unroll
                    for (int n = 0; n < 2; ++n) xv[m][bj][n] = *(const unsigned long long*)(xn + (size_t)(row0 + ai * HALF + m * 16) * ld + col0 + bj * HALF + n * 16);
#pragma unroll
            for (int m = 0; m < 4; ++m) { const int row = row0 + ai * HALF + m * 16; const size_t off = (size_t)row * ld + col0; float ss = 0.f;
#pragma unroll
                for (int bj = 0; bj < 2; ++bj)
#pragma unroll
                    for (int n = 0; n < 2; ++n) { const size_t idx = off + bj * HALF + n * 16; const unsigned long long w = xv[m][bj][n];
                        const unsigned lo = (unsigned)w, hi = (unsigned)(w >> 32);
                        const f32x4 r = (f32x4){__uint_as_float(lo << 16), __uint_as_float(lo & 0xffff0000u), __uint_as_float(hi << 16), __uint_as_float(hi & 0xffff0000u)} * rg[bj][n] * ri[ai][m] + acc[ai][bj][m][n];
                        ss += (r[0] * r[0] + r[1] * r[1]) + (r[2] * r[2] + r[3] * r[3]);
                        const f32x4 y = r * gv[bj][n];
                        st8(xn + idx, (unsigned long long)cvt_pk_bf16(y[0], y[1]) | ((unsigned long long)cvt_pk_bf16(y[2], y[3]) << 32)); }
                ss += __shfl_xor(ss, 16); ss += __shfl_xor(ss, 32);
                if (fq == 0) (void)__hip_atomic_fetch_add(rowss + row, ss, __ATOMIC_RELAXED, __HIP_MEMORY_SCOPE_AGENT); } }
    }
};
struct EpiResBf16G {
    static constexpr bool PERM = false, AFTER_DRAIN = false;
    bf16_t* xn; int ld; const float* gain; float* rowss;
    __device__ __forceinline__ void operator()(const f32x4 (&acc)[2][2][4][2], const Unit& u, int wr, int wc, int fr, int fq) const {
        const int row0 = u.pm * BM + wr * 64 + fr, col0 = u.pn * BM + wc * 32 + 4 * fq;
        f32x4 rg[2][2];
#pragma unroll
        for (int bj = 0; bj < 2; ++bj)
#pragma unroll
            for (int n = 0; n < 2; ++n) { const f32x4 g = *(const f32x4*)(gain + col0 + bj * HALF + n * 16); rg[bj][n] = (f32x4){1.f / g[0], 1.f / g[1], 1.f / g[2], 1.f / g[3]}; }
#pragma unroll
        for (int ai = 0; ai < 2; ++ai) {
            unsigned long long xv[4][2][2];
#pragma unroll
            for (int m = 0; m < 4; ++m)
#pragma unroll
                for (int bj = 0; bj < 2; ++bj)
#pragma unroll
                    for (int n = 0; n < 2; ++n) xv[m][bj][n] = *(const unsigned long long*)(xn + (size_t)(row0 + ai * HALF + m * 16) * ld + col0 + bj * HALF + n * 16);
#pragma unroll
            for (int m = 0; m < 4; ++m) { const int row = row0 + ai * HALF + m * 16; const size_t off = (size_t)row * ld + col0; float ss = 0.f;
#pragma unroll
                for (int bj = 0; bj < 2; ++bj)
#pragma unroll
                    for (int n = 0; n < 2; ++n) { const size_t idx = off + bj * HALF + n * 16; const unsigned long long w = xv[m][bj][n];
                        const unsigned lo = (unsigned)w, hi = (unsigned)(w >> 32);
                        const f32x4 r = (f32x4){__uint_as_float(lo << 16), __uint_as_float(lo & 0xffff0000u), __uint_as_float(hi << 16), __uint_as_float(hi & 0xffff0000u)} * rg[bj][n] + acc[ai][bj][m][n];
                        ss += (r[0] * r[0] + r[1] * r[1]) + (r[2] * r[2] + r[3] * r[3]);
                        st8(xn + idx, (unsigned long long)cvt_pk_bf16(r[0], r[1]) | ((unsigned long long)cvt_pk_bf16(r[2], r[3]) << 32)); }
                ss += __shfl_xor(ss, 16); ss += __shfl_xor(ss, 32);
                if (fq == 0) (void)__hip_atomic_fetch_add(rowss + row, ss, __ATOMIC_RELAXED, __HIP_MEMORY_SCOPE_AGENT); } }
    }
};
template <class Epi, class Sched, bool ALIGN_EPI = false, bool SP2 = false>
__device__ __forceinline__ void gemm_phase(PG8_LAS unsigned char* lds, const Gemm g, const Sched& S, const Epi& E) {
    const int tid = threadIdx.x, wid = __builtin_amdgcn_readfirstlane(tid >> 6), lane = tid & 63, wr = wid >> 2, wc = wid & 3, fr = lane & 15, fq = lane >> 4;
    const int K = g.K, nt = K / BK;
    unsigned voffA[2], voffB[2];
#pragma unroll
    for (int i = 0; i < 2; ++i) { int R, C; stage_rc(tid * 16 + i * 8192, R, C); const int Rb = Epi::PERM ? ((R & ~31) + perm32(R & 31)) : R;
        voffA[i] = (unsigned)(R * K + C) * 2u; voffB[i] = (unsigned)(Rb * K + C) * 2u; }
    const size_t kstep = (size_t)(BK * 2);
    const size_t hstep = (size_t)HALF * K * 2;
    const size_t tstep = 2 * hstep;
    const unsigned ldsw = (unsigned)wid * 1024u;
    const int aoff = lds_byte(wr * 64 + fr, fq * 8), boff = lds_byte(wc * 32 + fr, fq * 8);
#define PG8_SA(b, h) (((b) * 2 + (h)) * HTB)
#define PG8_SB(b, h) ((4 + (b) * 2 + (h)) * HTB)
#define PG8_STAGE(bufoff, gbase, voff) do { _Pragma("unroll") for (int _i = 0; _i < 2; ++_i) \
        __builtin_amdgcn_global_load_lds((const unsigned*)((const char*)(gbase) + (voff)[_i]), (PG8_LAS unsigned*)(lds + (bufoff) + ldsw + _i * 8192), 16, 0, 0); } while (0)
#define PG8_LDA(dst, b, h) do { _Pragma("unroll") for (int m = 0; m < 4; ++m) _Pragma("unroll") for (int k = 0; k < 2; ++k) dst[m][k] = *(const PG8_LAS bf16x8*)(lds + PG8_SA(b, h) + aoff + m * 2048 + k * 1024); } while (0)
#define PG8_LDB(dst, b, h) do { _Pragma("unroll") for (int n = 0; n < 2; ++n) _Pragma("unroll") for (int k = 0; k < 2; ++k) dst[n][k] = *(const PG8_LAS bf16x8*)(lds + PG8_SB(b, h) + boff + n * 2048 + k * 1024); } while (0)
#define PG8_MMA(ai, bj, At, Bt) do { __builtin_amdgcn_s_setprio(1); _Pragma("unroll") for (int m = 0; m < 4; ++m) _Pragma("unroll") for (int n = 0; n < 2; ++n) _Pragma("unroll") for (int k = 0; k < 2; ++k) \
        acc[ai][bj][m][n] = __builtin_amdgcn_mfma_f32_16x16x32_bf16(Bt[n][k], At[m][k], acc[ai][bj][m][n], 0, 0, 0); __builtin_amdgcn_s_setprio(0); } while (0)
#define PG8_WAIT_V(n) asm volatile("s_waitcnt vmcnt(" #n ")" ::: "memory")
#define PG8_WAIT_L(n) asm volatile("s_waitcnt lgkmcnt(" #n ")" ::: "memory")
#define PG8_BAR __builtin_amdgcn_s_barrier()
#define PG8_SCHED __builtin_amdgcn_sched_barrier(0)
    Unit cur, nxt; int ui = 0;
    if (!S.next(0, cur)) return;
    f32x4 acc[2][2][4][2];
#pragma unroll
    for (int a = 0; a < 2; ++a)
#pragma unroll
        for (int b = 0; b < 2; ++b)
#pragma unroll
            for (int m = 0; m < 4; ++m)
#pragma unroll
                for (int n = 0; n < 2; ++n) acc[a][b][m][n] = (f32x4){0.f, 0.f, 0.f, 0.f};
    bf16x8 At[4][2], B0[2][2], B1[2][2];
    const char* cA = (const char*)g.A + (size_t)cur.pm * tstep; const char* cB = (const char*)g.Bt + (size_t)cur.pn * tstep;
    S.a_ready(cur);
    if constexpr (SP2) {
        PG8_STAGE(PG8_SB(0, 0), cB, voffB); PG8_STAGE(PG8_SB(0, 1), cB + hstep, voffB); PG8_STAGE(PG8_SA(0, 0), cA, voffA); PG8_STAGE(PG8_SA(0, 1), cA + hstep, voffA);
        if (wr == 1) PG8_BAR;
        PG8_WAIT_V(2); PG8_BAR;
        PG8_STAGE(PG8_SB(1, 0), cB + kstep, voffB); PG8_STAGE(PG8_SA(1, 0), cA + kstep, voffA); PG8_STAGE(PG8_SB(1, 1), cB + hstep + kstep, voffB);
        PG8_WAIT_V(6); PG8_BAR;
    } else {
        PG8_STAGE(PG8_SB(0, 0), cB, voffB); PG8_STAGE(PG8_SA(0, 0), cA, voffA); PG8_STAGE(PG8_SB(0, 1), cB + hstep, voffB); PG8_STAGE(PG8_SA(0, 1), cA + hstep, voffA);
        if (wr == 1) PG8_BAR;
        PG8_WAIT_V(4); PG8_BAR;
        PG8_STAGE(PG8_SB(1, 0), cB + kstep, voffB); PG8_STAGE(PG8_SA(1, 0), cA + kstep, voffA); PG8_STAGE(PG8_SB(1, 1), cB + hstep + kstep, voffB);
        PG8_WAIT_V(6); PG8_BAR;
    }
    for (;;) {
        const bool has_next = S.next(ui + 1, nxt);
        const char* nA = has_next ? (const char*)g.A + (size_t)nxt.pm * tstep : cA; const char* nB = has_next ? (const char*)g.Bt + (size_t)nxt.pn * tstep : cB;
        for (int t = 0; t < nt; t += 2) {
            const bool last = (t == nt - 2);
            const char* a1 = cA + (size_t)(t + 1) * kstep;
            const char* a2 = last ? nA : cA + (size_t)(t + 2) * kstep; const char* b2 = last ? nB : cB + (size_t)(t + 2) * kstep;
            const char* a3 = a2 + kstep; const char* b3 = b2 + kstep;
            if (last && has_next) S.a_ready(nxt);
            if constexpr (SP2) {
            PG8_LDB(B0, 0, 0); PG8_LDB(B1, 0, 1); PG8_SCHED; PG8_LDA(At, 0, 0); PG8_STAGE(PG8_SA(1, 1), a1 + hstep, voffA);
            PG8_WAIT_V(8); PG8_WAIT_L(0); PG8_BAR; PG8_MMA(0, 0, At, B0); PG8_MMA(0, 1, At, B1); PG8_BAR; PG8_SCHED;
            PG8_LDA(At, 0, 1); PG8_STAGE(PG8_SB(0, 0), b2, voffB); PG8_STAGE(PG8_SB(0, 1), b2 + hstep, voffB); PG8_STAGE(PG8_SA(0, 0), a2, voffA);
            PG8_WAIT_V(8); PG8_WAIT_L(0); PG8_BAR; PG8_MMA(1, 0, At, B0); PG8_MMA(1, 1, At, B1); PG8_BAR; PG8_SCHED;
            PG8_LDB(B0, 1, 0); PG8_LDB(B1, 1, 1); PG8_SCHED; PG8_LDA(At, 1, 0); PG8_STAGE(PG8_SA(0, 1), a2 + hstep, voffA);
            PG8_WAIT_V(8); PG8_WAIT_L(0); PG8_BAR; PG8_MMA(0, 0, At, B0); PG8_MMA(0, 1, At, B1); PG8_BAR; PG8_SCHED;
            PG8_LDA(At, 1, 1); PG8_STAGE(PG8_SB(1, 0), b3, voffB); PG8_STAGE(PG8_SB(1, 1), b3 + hstep, voffB); PG8_STAGE(PG8_SA(1, 0), a3, voffA);
            PG8_WAIT_V(8); PG8_WAIT_L(0); PG8_BAR; PG8_MMA(1, 0, At, B0); PG8_MMA(1, 1, At, B1); PG8_BAR; PG8_SCHED;
            } else {
            PG8_LDB(B0, 0, 0); PG8_SCHED; PG8_LDA(At, 0, 0); PG8_STAGE(PG8_SA(1, 1), a1 + hstep, voffA);
            PG8_WAIT_L(8); PG8_BAR; PG8_WAIT_L(0); PG8_MMA(0, 0, At, B0); PG8_BAR; PG8_SCHED;
            PG8_LDB(B1, 0, 1); PG8_STAGE(PG8_SB(0, 0), b2, voffB);
            PG8_BAR; PG8_WAIT_L(0); PG8_MMA(0, 1, At, B1); PG8_BAR;
            PG8_LDA(At, 0, 1); PG8_STAGE(PG8_SA(0, 0), a2, voffA);
            PG8_BAR; PG8_WAIT_L(0); PG8_MMA(1, 0, At, B0); PG8_BAR; PG8_SCHED;
            PG8_STAGE(PG8_SB(0, 1), b2 + hstep, voffB);
            PG8_WAIT_V(6); PG8_BAR; PG8_MMA(1, 1, At, B1); PG8_BAR;
            PG8_LDB(B0, 1, 0); PG8_SCHED; PG8_LDA(At, 1, 0); PG8_STAGE(PG8_SA(0, 1), a2 + hstep, voffA);
            PG8_WAIT_L(8); PG8_BAR; PG8_WAIT_L(0); PG8_MMA(0, 0, At, B0); PG8_BAR; PG8_SCHED;
            PG8_LDB(B1, 1, 1); PG8_STAGE(PG8_SB(1, 0), b3, voffB);
            PG8_BAR; PG8_WAIT_L(0); PG8_MMA(0, 1, At, B1); PG8_BAR;
            PG8_LDA(At, 1, 1); PG8_STAGE(PG8_SA(1, 0), a3, voffA);
            PG8_BAR; PG8_WAIT_L(0); PG8_MMA(1, 0, At, B0); PG8_BAR; PG8_SCHED;
            PG8_STAGE(PG8_SB(1, 1), b3 + hstep, voffB);
            PG8_WAIT_V(6); PG8_BAR; PG8_MMA(1, 1, At, B1); PG8_BAR;
            }
        }
        if constexpr (ALIGN_EPI) { if (wr == 0) PG8_BAR; }
        if constexpr (!Epi::AFTER_DRAIN) { E(acc, cur, wr, wc, fr, fq); S.done(cur); }
        if (!has_next) break;
#pragma unroll
        for (int a = 0; a < 2; ++a)
#pragma unroll
            for (int b = 0; b < 2; ++b)
#pragma unroll
                for (int m = 0; m < 4; ++m)
#pragma unroll
                    for (int n = 0; n < 2; ++n) acc[a][b][m][n] = (f32x4){0.f, 0.f, 0.f, 0.f};
        cur = nxt; cA = nA; cB = nB; ++ui;
        if constexpr (ALIGN_EPI) { if (wr == 1) PG8_BAR; }
    }
    PG8_WAIT_V(0);
    if constexpr (!ALIGN_EPI) { if (wr == 0) PG8_BAR; }
    PG8_BAR;
    if constexpr (Epi::AFTER_DRAIN) { E.fused(acc, cur, wr, wc, fr, fq, lds, wid, lane); S.done(cur); }
#undef PG8_SA
#undef PG8_SB
#undef PG8_STAGE
#undef PG8_LDA
#undef PG8_LDB
#undef PG8_MMA
#undef PG8_WAIT_V
#undef PG8_WAIT_L
#undef PG8_BAR
#undef PG8_SCHED
}
}
namespace att {
using bf16 = __hip_bfloat16;
constexpr int   D = 128, NW = 8, QBLK = 32, KVBLK = 64;
constexpr float SCALE = 0.088388347648318440f;
constexpr float THR = 8.f;
constexpr int SDEPTH = 2;
constexpr int LDQ = 4608, LDK = 4608, LDO = 2048, LDG = 4608;
constexpr size_t SHM_V = KVBLK * D * 2, SHM_K = KVBLK * D * 2, SHM_ATTN = 2 * SHM_V + 2 * SHM_K + NW * 64 * 4;
constexpr int OST_OFF = 67584;
using bf16x8 = __attribute__((ext_vector_type(8))) short;
using s16x4  = __attribute__((ext_vector_type(4))) short;
using f32x16 = __attribute__((ext_vector_type(16))) float;
using f32x8  = __attribute__((ext_vector_type(8))) float;
using u32x4  = __attribute__((ext_vector_type(4))) unsigned;
#define KSWZ(row, colB) ((row) * 256 + ((colB) ^ (((row) & 7) << 4)))
#define SBAR() __builtin_amdgcn_sched_barrier(0)
__device__ __forceinline__ int crow(int r, int hi) { return (r & 3) + 8 * (r >> 2) + 4 * hi; }
__device__ __forceinline__ unsigned cvtpk(float lo, float hi) {
  unsigned r; asm volatile("v_cvt_pk_bf16_f32 %0, %1, %2" : "=v"(r) : "v"(lo), "v"(hi)); return r;
}
template <typename TIn> struct Stage;
template <> struct Stage<bf16>  { using T = bf16x8;
  __device__ static __forceinline__ T ld8(const bf16* p) { return *reinterpret_cast<const bf16x8*>(p); }
  __device__ static __forceinline__ bf16x8 tobf(T x) { return x; } };
template <> struct Stage<float> { using T = f32x8;
  __device__ static __forceinline__ T ld8(const float* p) { return *reinterpret_cast<const f32x8*>(p); }
  __device__ static __forceinline__ bf16x8 tobf(T x) {
    u32x4 w = {cvtpk(x[0], x[1]), cvtpk(x[2], x[3]), cvtpk(x[4], x[5]), cvtpk(x[6], x[7])}; return *reinterpret_cast<bf16x8*>(&w); } };

__device__ __forceinline__ void partialSM(f32x16& p0, f32x16& p1, float& m_reg, float& mn, float& alpha) {
  constexpr float C = SCALE * 1.4426950408889634f;
  float pmax = p0[0]; for (int r = 1; r < 16; ++r) pmax = fmaxf(pmax, p0[r]); for (int r = 0; r < 16; ++r) pmax = fmaxf(pmax, p1[r]);
  { auto rr = __builtin_amdgcn_permlane32_swap(__float_as_uint(pmax), __float_as_uint(pmax), false, false);
    pmax = fmaxf(__uint_as_float(rr[0]), __uint_as_float(rr[1])); }
  if (__builtin_expect(__all(pmax - m_reg <= THR / SCALE), 1)) { mn = m_reg; alpha = 1.f; }
  else { mn = fmaxf(m_reg, pmax); alpha = __builtin_amdgcn_exp2f((m_reg - mn) * C); m_reg = mn; }
  float mnC = -mn * C;
  for (int r = 0; r < 16; ++r) p0[r] = fmaf(p0[r], C, mnC); for (int r = 0; r < 16; ++r) p1[r] = fmaf(p1[r], C, mnC);
  for (int r = 0; r < 16; ++r) p0[r] = __builtin_amdgcn_exp2f(p0[r]);
}
__device__ __forceinline__ void finishSM(f32x16& p0, f32x16& p1, float alpha, float& l_reg, bf16x8& pa0, bf16x8& pa1, bf16x8& pa2, bf16x8& pa3) {
  for (int r = 0; r < 16; ++r) p1[r] = __builtin_amdgcn_exp2f(p1[r]);
  float ps = 0; for (int r = 0; r < 16; ++r) ps += p0[r]; for (int r = 0; r < 16; ++r) ps += p1[r];
  { auto rr = __builtin_amdgcn_permlane32_swap(__float_as_uint(ps), __float_as_uint(ps), false, false);
    ps = __uint_as_float(rr[0]) + __uint_as_float(rr[1]); }
  l_reg = l_reg * alpha + ps;
#define PK4(P, BASE, OUT) do { unsigned a0 = cvtpk(P[BASE + 0], P[BASE + 1]), a1 = cvtpk(P[BASE + 2], P[BASE + 3]);   \
    unsigned b0 = cvtpk(P[BASE + 4], P[BASE + 5]), b1 = cvtpk(P[BASE + 6], P[BASE + 7]);                              \
    auto r0 = __builtin_amdgcn_permlane32_swap(a0, b0, false, false); auto r1 = __builtin_amdgcn_permlane32_swap(a1, b1, false, false); \
    u32x4 w = {r0[0], r1[0], r0[1], r1[1]}; OUT = *reinterpret_cast<bf16x8*>(&w); } while (0)
  PK4(p0, 0, pa0); PK4(p0, 8, pa1); PK4(p1, 0, pa2); PK4(p1, 8, pa3);
#undef PK4
}
__device__ __forceinline__ void qkt(f32x16& p0, f32x16& p1, const bf16* Ks, const bf16x8* qr, int r32, int hi) {
  p0 = f32x16{}; p1 = f32x16{};
  for (int d0 = 0; d0 < 8; ++d0) { int cb = (d0 * 16 + hi * 8) * 2;
    bf16x8 b0 = *reinterpret_cast<const bf16x8*>((const char*)Ks + KSWZ(r32, cb));
    bf16x8 b1 = *reinterpret_cast<const bf16x8*>((const char*)Ks + KSWZ(32 + r32, cb));
    p0 = __builtin_amdgcn_mfma_f32_32x32x16_bf16(b0, qr[d0], p0, 0, 0, 0);
    p1 = __builtin_amdgcn_mfma_f32_32x32x16_bf16(b1, qr[d0], p1, 0, 0, 0); }
}
__device__ __forceinline__ int v_st(int k, int c) { const int kk = (k & ~0xC) | ((k & 4) << 1) | ((k & 8) >> 1); return ((kk >> 3) * 4 + (c >> 5)) * 512 + ((kk & 7) * 32 + (c & 31)) * 2; }
__device__ __forceinline__ int v_rd_base(int lane) { return ((lane & 3) << 3) | (((lane >> 2) & 3) << 6) | (((lane >> 4) & 1) << 5) | (((lane >> 5) & 1) << 8); }
constexpr int v_rd_off(int d0, int ks, int half) { return d0 * 512 + ks * 4096 + half * 2048; }
template <int OFF> __device__ __forceinline__ s16x4 tr_read(int vb) {
  s16x4 r; asm volatile("ds_read_b64_tr_b16 %0, %1 offset:%2" : "=&v"(r) : "v"(vb), "i"(OFF) : "memory"); return r;
}
template <int D0> __device__ __forceinline__ void pv_one(f32x16& od, int vb, bf16x8 pa0, bf16x8 pa1, bf16x8 pa2, bf16x8 pa3) {
  const s16x4 l0 = tr_read<v_rd_off(D0, 0, 0)>(vb), h0 = tr_read<v_rd_off(D0, 0, 1)>(vb), l1 = tr_read<v_rd_off(D0, 1, 0)>(vb), h1 = tr_read<v_rd_off(D0, 1, 1)>(vb);
  const s16x4 l2 = tr_read<v_rd_off(D0, 2, 0)>(vb), h2 = tr_read<v_rd_off(D0, 2, 1)>(vb), l3 = tr_read<v_rd_off(D0, 3, 0)>(vb), h3 = tr_read<v_rd_off(D0, 3, 1)>(vb);
  asm volatile("s_waitcnt lgkmcnt(0)" ::: "memory"); SBAR();
#define PK(L, H) (bf16x8){L[0], L[1], L[2], L[3], H[0], H[1], H[2], H[3]}
  od = __builtin_amdgcn_mfma_f32_32x32x16_bf16(pa0, PK(l0, h0), od, 0, 0, 0);
  od = __builtin_amdgcn_mfma_f32_32x32x16_bf16(pa1, PK(l1, h1), od, 0, 0, 0);
  od = __builtin_amdgcn_mfma_f32_32x32x16_bf16(pa2, PK(l2, h2), od, 0, 0, 0);
  od = __builtin_amdgcn_mfma_f32_32x32x16_bf16(pa3, PK(l3, h3), od, 0, 0, 0);
#undef PK
}
__device__ __forceinline__ void pv_d0(f32x16* o, int vb, bf16x8 pa0, bf16x8 pa1, bf16x8 pa2, bf16x8 pa3) {
  pv_one<0>(o[0], vb, pa0, pa1, pa2, pa3); pv_one<1>(o[1], vb, pa0, pa1, pa2, pa3); pv_one<2>(o[2], vb, pa0, pa1, pa2, pa3); pv_one<3>(o[3], vb, pa0, pa1, pa2, pa3);
}

template <typename TQ>
__device__ __forceinline__ void attn_dense_body(const TQ* __restrict__ Qb, const bf16* __restrict__ Kh, const bf16* __restrict__ Vh,
                                                unsigned short* __restrict__ Ob, const unsigned short* __restrict__ Gb, int seq, char* lds) {
  using St = Stage<bf16>; using SQ = Stage<TQ>;
  const int tid = threadIdx.x, wid = tid >> 6, lane = tid & 63, r32 = lane & 31, hi = lane >> 5;
  bf16* V_lds = (bf16*)lds; bf16* K_lds = (bf16*)(lds + 2 * SHM_V);
  float* ws = (float*)(lds + 2 * SHM_V + 2 * SHM_K) + wid * 64; float* li_l = ws; float* al_l = ws + 32;
  float m_reg = -1e30f, l_reg = 0; f32x16 o[4] = {}; bf16x8 qr[8];
  const TQ* Qw = Qb + (long)(wid * QBLK + r32) * LDQ + hi * 8;
#pragma unroll
  for (int d0 = 0; d0 < 8; ++d0) qr[d0] = SQ::tobf(SQ::ld8(Qw + d0 * 16));
  const int sr = tid >> 4, sc = (tid & 15) * 8, vst0 = v_st(sr, sc), vst1 = v_st(32 + sr, sc);
  const int vb0 = (int)(uintptr_t)V_lds + v_rd_base(lane);
  struct { typename St::T vs0, vs1, ks0, ks1; } sr_[SDEPTH];
#define SLOAD(i, k0) do { sr_[i].vs0 = St::ld8(&Vh[(long)((k0) + sr) * LDK + sc]); sr_[i].vs1 = St::ld8(&Vh[(long)((k0) + 32 + sr) * LDK + sc]); \
    sr_[i].ks0 = St::ld8(&Kh[(long)((k0) + sr) * LDK + sc]); sr_[i].ks1 = St::ld8(&Kh[(long)((k0) + 32 + sr) * LDK + sc]); } while (0)
#define SWRITE(b, i) do { *(bf16x8*)((char*)V_lds + (b) * SHM_V + vst0) = St::tobf(sr_[i].vs0);          \
    *(bf16x8*)((char*)V_lds + (b) * SHM_V + vst1) = St::tobf(sr_[i].vs1); int kc = sc * 2;               \
    *(bf16x8*)((char*)K_lds + (b) * SHM_K + KSWZ(sr, kc)) = St::tobf(sr_[i].ks0);                       \
    *(bf16x8*)((char*)K_lds + (b) * SHM_K + KSWZ(32 + sr, kc)) = St::tobf(sr_[i].ks1); } while (0)
#define SWAIT() do { if constexpr (SDEPTH == 2) asm volatile("s_waitcnt vmcnt(4)" ::: "memory"); else asm volatile("s_waitcnt vmcnt(0)" ::: "memory"); } while (0)
#define RESC(a) do { if (__any((a) < 1.f)) { if (hi == 0) al_l[r32] = (a); asm volatile("s_waitcnt lgkmcnt(0)" ::: "memory"); \
    for (int d = 0; d < 4; ++d) for (int r = 0; r < 16; ++r) o[d][r] *= al_l[crow(r, hi)]; } } while (0)
  f32x16 pA0, pA1, pB0, pB1; float mnA, mnB, alA, alB; bf16x8 pa0, pa1, pa2, pa3; const int NT = seq / KVBLK;
  constexpr int SE = 0, SO = SDEPTH - 1;
  SLOAD(SE, 0); asm volatile("s_waitcnt vmcnt(0)" ::: "memory"); SWRITE(0, SE); __syncthreads();
  qkt(pA0, pA1, K_lds, qr, r32, hi); partialSM(pA0, pA1, m_reg, mnA, alA);
  SLOAD(SO, KVBLK); if constexpr (SDEPTH == 2) { if (2 < NT) SLOAD(SE, 2 * KVBLK); }
  SWAIT(); SWRITE(1, SO); __syncthreads();
  for (int j = 1; j + 1 < NT; j += 2) {
    SBAR(); qkt(pB0, pB1, (bf16*)((char*)K_lds + SHM_K), qr, r32, hi);
    finishSM(pA0, pA1, alA, l_reg, pa0, pa1, pa2, pa3); SBAR();
    SLOAD(SO, (j + SDEPTH) * KVBLK); SBAR();
    pv_d0(o, vb0, pa0, pa1, pa2, pa3); partialSM(pB0, pB1, m_reg, mnB, alB);
    __syncthreads(); SWAIT(); SWRITE(0, SE);
    RESC(alB); __syncthreads();
    SBAR(); qkt(pA0, pA1, K_lds, qr, r32, hi);
    finishSM(pB0, pB1, alB, l_reg, pa0, pa1, pa2, pa3); SBAR();
    if (SDEPTH == 1 || j + 3 < NT) SLOAD(SE, (j + 1 + SDEPTH) * KVBLK); SBAR();
    pv_d0(o, vb0 + (int)SHM_V, pa0, pa1, pa2, pa3); partialSM(pA0, pA1, m_reg, mnA, alA);
    __syncthreads(); SWAIT(); SWRITE(1, SO);
    RESC(alA); __syncthreads();
  }
  SBAR(); qkt(pB0, pB1, (bf16*)((char*)K_lds + SHM_K), qr, r32, hi);
  finishSM(pA0, pA1, alA, l_reg, pa0, pa1, pa2, pa3); SBAR();
  pv_d0(o, vb0, pa0, pa1, pa2, pa3); partialSM(pB0, pB1, m_reg, mnB, alB);
  __syncthreads(); RESC(alB);
  finishSM(pB0, pB1, alB, l_reg, pa0, pa1, pa2, pa3); SBAR();
  pv_d0(o, vb0 + (int)SHM_V, pa0, pa1, pa2, pa3);
  if (hi == 0) li_l[r32] = l_reg; asm volatile("s_waitcnt lgkmcnt(0)" ::: "memory");
  float rli[16];
#pragma unroll
  for (int r = 0; r < 16; ++r) rli[r] = __builtin_amdgcn_rcpf(li_l[crow(r, hi)]);
  int lane_e = lane, wide = wid; asm volatile("" : "+v"(lane_e), "+v"(wide));
  char* ost = lds + OST_OFF + wide * (QBLK * 272);
  { char* osw = ost + (4 * (lane_e >> 5)) * 272 + (lane_e & 31) * 2;
#pragma unroll
  for (int r = 0; r < 16; ++r) { const int orow = (r & 3) + 8 * (r >> 2);
#pragma unroll
    for (int d0 = 0; d0 < 4; ++d0) { unsigned uu = __float_as_uint(o[d0][r] * rli[r]); uu = (uu + 0x7fffu + ((uu >> 16) & 1u)) >> 16;
      *(unsigned short*)(osw + orow * 272 + d0 * 64) = (unsigned short)uu; } } }
  asm volatile("s_waitcnt lgkmcnt(0)" ::: "memory");
  const int rowl = lane_e >> 4, ch = lane_e & 15;
  unsigned short* Ow = Ob + (long)(wide * QBLK + rowl) * LDO + ch * 8; const unsigned short* Gw = Gb + (long)(wide * QBLK + rowl) * LDG + ch * 8;
#pragma unroll
  for (int i = 0; i < 8; ++i) { if ((i & 3) == 0) SBAR();
    const u32x4 ov = *reinterpret_cast<const u32x4*>(ost + (rowl + 4 * i) * 272 + ch * 16);
    const u32x4 gv = *reinterpret_cast<const u32x4*>(Gw + (long)(4 * i) * LDG);
    u32x4 res;
#pragma unroll
    for (int e = 0; e < 4; ++e) { const float g0 = __uint_as_float(gv[e] << 16), g1 = __uint_as_float(gv[e] & 0xffff0000u);
      const float o0 = __uint_as_float(ov[e] << 16), o1 = __uint_as_float(ov[e] & 0xffff0000u);
      res[e] = cvtpk(o0 * g0 * __builtin_amdgcn_rcpf(1.f + __expf(-g0)), o1 * g1 * __builtin_amdgcn_rcpf(1.f + __expf(-g1))); }
    *reinterpret_cast<u32x4*>(Ow + (long)(4 * i) * LDO) = res; }
#undef SLOAD
#undef SWRITE
#undef SWAIT
#undef RESC
}
}
#define LAS __attribute__((address_space(3)))
typedef unsigned short u16;
typedef short bf16x8 __attribute__((ext_vector_type(8)));
typedef float f32x4 __attribute__((ext_vector_type(4)));
typedef unsigned u32x4 __attribute__((ext_vector_type(4)));
typedef unsigned u32x2 __attribute__((ext_vector_type(2)));

constexpr int NWAVES = 8;
#ifndef PG8_SP2
#define PG8_SP2 true
#endif
constexpr int BATCH = 8, SEQ = 2048, DM = 2048, M = BATCH * SEQ;
constexpr int EVEN_IN = 4608, ODD_IN = 8224, ODD_MAIN = 8192;
constexpr float EPS = 1e-6f;
constexpr int C_Q = 0, C_K = 1024, C_V = 1280, C_GA = 1536, C_XL = 2560, C_GL = 3584;
constexpr int D_Q = 0, D_K = 1024, D_V = 2048, D_O = 4096, D_Z = 6144;
constexpr int NPHASES = 11;

constexpr size_t MiB = 1u << 20;
constexpr size_t WS_W0T = 0;
constexpr size_t WS_WO0T = 18 * MiB;
constexpr size_t WS_W1T = 26 * MiB;
constexpr size_t WS_WO1T = 58 * MiB;
constexpr size_t WS_WG1T = 66 * MiB;
constexpr size_t WS_LW = 67 * MiB;
constexpr size_t WS_ROPE = 68 * MiB;
constexpr size_t WS_AGG = 69 * MiB;
constexpr size_t WS_GATES = 71 * MiB;
constexpr size_t WS_SUMSQ = 73 * MiB;
constexpr size_t WS_XN = 74 * MiB;
constexpr size_t WS_MIX = 138 * MiB;
constexpr size_t WS_BIG = 202 * MiB;
constexpr size_t WS_HL = WS_BIG + 144 * MiB, WS_PP = WS_HL + 64 * MiB, WS_END = WS_PP + 64 * MiB;

constexpr size_t WS_CTL = 480 * MiB, CTL_BYTES = 16384, WS_TOTAL = WS_CTL + CTL_BYTES;
constexpr int LDS_BYTES = 147456;
constexpr int LDS_MISC = LDS_BYTES - 64;

struct Args { const float* in[18]; float* out; unsigned char* ws; int ph_lo, ph_hi; };

struct Frame {
    LAS unsigned char* lds; char* lds_g;
    int tid, lane, wave, G, gw, NGW;
    const float *x, *norm_gain, *final_gain, *w_in0, *w_out0, *qg, *kg, *conv_w, *conv_b, *lru_wa, *lru_ba, *lru_wx, *lru_bx, *lru_lam, *w_in1, *gate_bias, *norm1, *w_out1;
    float* out;
    unsigned char* ws;
};

__device__ __forceinline__ float bf2f(unsigned b) { return __uint_as_float(b << 16); }
__device__ __forceinline__ unsigned f2bf(float f) { unsigned u = __float_as_uint(f); return (u + 0x7fffu + ((u >> 16) & 1u)) >> 16; }
__device__ __forceinline__ unsigned pk2(float lo, float hi) { return f2bf(lo) | (f2bf(hi) << 16); }
__device__ __forceinline__ float lo16(unsigned w) { return __uint_as_float(w << 16); }
__device__ __forceinline__ float hi16(unsigned w) { return __uint_as_float(w & 0xffff0000u); }
__device__ __forceinline__ float sigmoidf_(float x) { return __builtin_amdgcn_rcpf(1.f + __expf(-x)); }
__device__ __forceinline__ float siluf_(float x) { return x * __builtin_amdgcn_rcpf(1.f + __expf(-x)); }
__device__ __forceinline__ float logsigf_(float x) { return fminf(x, 0.f) - log1pf(__expf(-fabsf(x))); }
__device__ __forceinline__ float wave_sum(float v) {
#pragma unroll
    for (int o = 1; o < 64; o <<= 1) v += __shfl_xor(v, o);
    return v;
}
#define MFMA16(a, b, c) __builtin_amdgcn_mfma_f32_16x16x32_bf16((a), (b), (c), 0, 0, 0)

__device__ __forceinline__ void transpose_item(const float* W, int ldw, int k0, int n0, u16* WT, int ldt, int trow0, LAS float* scr, int lane) {
#pragma unroll
    for (int i = 0; i < 32; ++i) { const int kk = 2 * i + (lane >> 5); scr[kk * 33 + (lane & 31)] = W[(size_t)(k0 + kk) * ldw + n0 + (lane & 31)]; }
    asm volatile("s_waitcnt lgkmcnt(0)" ::: "memory");
    const int c = lane & 7;
#pragma unroll
    for (int j = 0; j < 4; ++j) { const int n = (lane >> 3) + 8 * j; const LAS float* s = scr + (8 * c) * 33 + n;
        u32x4 o; o.x = pk2(s[0 * 33], s[1 * 33]); o.y = pk2(s[2 * 33], s[3 * 33]); o.z = pk2(s[4 * 33], s[5 * 33]); o.w = pk2(s[6 * 33], s[7 * 33]);
        *(u32x4*)(WT + (size_t)(trow0 + n) * ldt + k0 + 8 * c) = o; }
    asm volatile("s_waitcnt lgkmcnt(0)" ::: "memory");
}
__device__ __forceinline__ void rms_row_to_bf16(const float* xrow, const float* gain, u16* orow, int lane, float* rinv) {
    const f32x4* xr = (const f32x4*)xrow + lane; const f32x4* gr = (const f32x4*)gain + lane;
    f32x4 v[8]; float s = 0.f;
#pragma unroll
    for (int j = 0; j < 8; ++j) { v[j] = xr[64 * j]; s += (v[j].x * v[j].x + v[j].y * v[j].y) + (v[j].z * v[j].z + v[j].w * v[j].w); }
    const float ms = wave_sum(s) * (1.f / DM) + EPS; const float r = rsqrtf(ms);
    if (lane == 0) *rinv = sqrtf(ms);
    unsigned long long* o8 = (unsigned long long*)orow + lane;
#pragma unroll
    for (int j = 0; j < 8; ++j) { const f32x4 g = gr[64 * j];
        o8[64 * j] = (unsigned long long)pk2(v[j].x * r * g.x, v[j].y * r * g.y) | ((unsigned long long)pk2(v[j].z * r * g.z, v[j].w * r * g.w) << 32); }
}
__device__ __forceinline__ void w1_item(Frame& F, int r, LAS float* scr) {
    const int kb = r / 257, nb = r % 257;
    if (nb < 256) transpose_item(F.w_in1, ODD_IN, 64 * kb, 32 * nb, ((u16*)(F.ws + WS_W1T)), DM, 32 * nb, scr, F.lane);
    else          transpose_item(F.w_in1, ODD_IN, 64 * kb, ODD_MAIN, ((u16*)(F.ws + WS_WG1T)), DM, 0, scr, F.lane);
}
__device__ __forceinline__ void wo0_item(Frame& F, int r, LAS float* scr) {
    const int kb = r / 64, nb = r % 64; transpose_item(F.w_out0, DM, 64 * kb, 32 * nb, ((u16*)(F.ws + WS_WO0T)), DM, 32 * nb, scr, F.lane);
}
__device__ __forceinline__ void wo1_item(Frame& F, int r, LAS float* scr) {
    const int kb = r / 64, nb = r % 64; transpose_item(F.w_out1, DM, 64 * kb, 32 * nb, ((u16*)(F.ws + WS_WO1T)), DM, 32 * nb, scr, F.lane);
}
__device__ __forceinline__ void p1_deferred(Frame& F) {
    LAS float* scr = (LAS float*)(F.lds + F.wave * 16384);
    for (int r = ((int)blockIdx.x - 128) * NWAVES + F.wave; r < 32 * 257; r += 128 * NWAVES) w1_item(F, r, scr);
    for (int r = ((int)blockIdx.x - 128) * NWAVES + F.wave; r < 32 * 64; r += 128 * NWAVES) wo0_item(F, r, scr);
    for (int r = ((int)blockIdx.x - 128) * NWAVES + F.wave; r < 32 * 64; r += 128 * NWAVES) wo1_item(F, r, scr);
}
__device__ __forceinline__ void p0_prologue(Frame& F) {
    LAS float* scr = (LAS float*)(F.lds + F.wave * 16384);
    constexpr int I0 = 32 * 144, I1 = 32 * 64, I2 = 32 * 257, I3 = 32 * 64, I4 = 256;
    constexpr int NITEMS = I0 + I1 + I2 + I3 + I4;
    for (int it = F.gw; it < NITEMS; it += F.NGW) {
        int r = it;
        if (r < I0) { const int kb = r / 144, nb = r % 144; transpose_item(F.w_in0, EVEN_IN, 64 * kb, 32 * nb, ((u16*)(F.ws + WS_W0T)), DM, 32 * nb, scr, F.lane); continue; } r -= I0;
        if (r < I1) { if (F.G != 256) wo0_item(F, r, scr); continue; } r -= I1;
        if (r < I2) { if (F.G != 256) w1_item(F, r, scr); continue; } r -= I2;
        if (r < I3) { if (F.G != 256) wo1_item(F, r, scr); continue; } r -= I3;
        {
            const int blk = r >> 3, sub = r & 7, kb = sub >> 2, nb = sub & 3;
            const int dir = blk >> 4, gate = (blk >> 3) & 1, n = blk & 7;
            const float* src = (gate ? F.lru_wx : F.lru_wa) + (size_t)(dir * 8 + n) * 16384;
            transpose_item(src, 128, 64 * kb, 32 * nb, ((u16*)(F.ws + WS_LW)) + (size_t)((dir * 2 + gate) * 8 + n) * 16384, 128, 32 * nb, scr, F.lane);
        }
    }
    {
        const int g = blockIdx.x * (NWAVES * 64) + F.tid;
        if (g < 64 * 32) { const int pos = g >> 5, i = g & 31;
            const float inv = exp2f(-(float)(2 * i) * (13.287712379549449f / 64.f));
            const float ang = (float)pos * inv;
            ((float*)(F.ws + WS_ROPE))[2 * g] = cosf(ang); ((float*)(F.ws + WS_ROPE))[2 * g + 1] = sinf(ang); }
    }
    for (int i = blockIdx.x * (NWAVES * 64) + F.tid; i < 2 * M; i += F.G * NWAVES * 64) ((float*)(F.ws + WS_SUMSQ))[i] = 0.f;
    for (int m = F.gw; m < M; m += F.NGW) rms_row_to_bf16(F.x + (size_t)m * DM, F.norm_gain, ((u16*)(F.ws + WS_XN)) + (size_t)m * DM, F.lane, ((float*)(F.ws + WS_SUMSQ)) + 3 * M + m);
}

__device__ __forceinline__ void qk_norm_rope(Frame& F) {
    const int half = F.lane >> 5, i = F.lane & 31, colh = i >> 4, j = 2 * (i & 15);
    const int e0 = colh * 64 + j;
    const float* gq = F.qg + e0; const float* gk = F.kg + e0;
    const float q0a = gq[0], q0b = gq[1], q1a = gq[32], q1b = gq[33], k0a = gk[0], k0b = gk[1], k1a = gk[32], k1b = gk[33];
    constexpr int TB = 4;
    for (int tok0 = F.gw; tok0 < M; tok0 += TB * F.NGW) {
        unsigned lo[TB][5], hi[TB][5]; f32x4 cs[TB];
#pragma unroll
        for (int q = 0; q < TB; ++q) { const int tok = tok0 + q * F.NGW; const bool ok = tok < M; const int tk = ok ? tok : tok0;
            const u16* p = ((u16*)(F.ws + WS_BIG)) + (size_t)tk * EVEN_IN + half * 128 + e0;
#pragma unroll
            for (int pp = 0; pp < 5; ++pp) { lo[q][pp] = *(const unsigned*)(p + pp * 256); hi[q][pp] = *(const unsigned*)(p + pp * 256 + 32); }
            const int t = tk & (SEQ - 1), pos = colh ? (t & 63) : (t >> 6);
            cs[q] = *(const f32x4*)(((const float*)(F.ws + WS_ROPE)) + (pos * 32 + j) * 2); }
#pragma unroll
        for (int q = 0; q < TB; ++q) { const int tok = tok0 + q * F.NGW; if (tok < M) {
            u16* p = ((u16*)(F.ws + WS_BIG)) + (size_t)tok * EVEN_IN + half * 128 + e0;
#pragma unroll
            for (int pp = 0; pp < 5; ++pp) {
                float x0a = lo16(lo[q][pp]), x0b = hi16(lo[q][pp]), x1a = lo16(hi[q][pp]), x1b = hi16(hi[q][pp]);
                float ss = (x0a * x0a + x0b * x0b) + (x1a * x1a + x1b * x1b);
#pragma unroll
                for (int o = 1; o < 32; o <<= 1) ss += __shfl_xor(ss, o);
                const float r = rsqrtf(ss * (1.f / 128.f) + EPS);
                x0a *= r * (pp < 4 ? q0a : k0a); x0b *= r * (pp < 4 ? q0b : k0b); x1a *= r * (pp < 4 ? q1a : k1a); x1b *= r * (pp < 4 ? q1b : k1b);
                *(unsigned*)(p + pp * 256) = pg8::cvt_pk_bf16(x0a * cs[q][0] - x1a * cs[q][1], x0b * cs[q][2] - x1b * cs[q][3]);
                *(unsigned*)(p + pp * 256 + 32) = pg8::cvt_pk_bf16(x0a * cs[q][1] + x1a * cs[q][0], x0b * cs[q][3] + x1b * cs[q][2]);
            } } }
    }
}

constexpr int LP = 136;
template <int DIR>
__device__ __forceinline__ void lru_dir(Frame& F, int b, int c, int n, LAS u16* XC, LAS u16* OH, LAS u16* OP) {
    const int wv = F.wave, lane = F.lane, fr = lane & 15, fq = lane >> 4;
    const int dch = n * 128 + 16 * wv + fr;
    bf16x8 Bf[2][4];
#pragma unroll
    for (int g = 0; g < 2; ++g)
#pragma unroll
        for (int kk = 0; kk < 4; ++kk) Bf[g][kk] = *(const bf16x8*)(((u16*)(F.ws + WS_LW)) + ((size_t)((DIR * 2 + g) * 8 + n) * 128 + 16 * wv + fr) * 128 + kk * 32 + fq * 8);
    f32x4 acc[2][8];
#pragma unroll
    for (int m = 0; m < 8; ++m) { acc[0][m] = (f32x4){0.f, 0.f, 0.f, 0.f}; acc[1][m] = (f32x4){0.f, 0.f, 0.f, 0.f}; }
#pragma unroll
    for (int m = 0; m < 8; ++m)
#pragma unroll
        for (int kk = 0; kk < 4; ++kk) { const bf16x8 a = *(const LAS bf16x8*)(XC + (16 * m + fr) * LP + kk * 32 + fq * 8);
            acc[0][m] = MFMA16(a, Bf[0][kk], acc[0][m]); acc[1][m] = MFMA16(a, Bf[1][kk], acc[1][m]); if (kk == 3 && (m & 1)) __builtin_amdgcn_sched_barrier(0); }
    const float ba = F.lru_ba[DIR * 1024 + dch], bx = F.lru_bx[DIR * 1024 + dch], lam = F.lru_lam[DIR * 1024 + dch];
    const float ls8 = 8.f * logsigf_(lam);
#pragma unroll
    for (int m = 0; m < 8; ++m)
#pragma unroll
        for (int j = 0; j < 4; ++j) { const int t = 16 * m + 4 * fq + j;
            const float xc = bf2f(XC[t * LP + 16 * wv + fr]);
            const float r = sigmoidf_(acc[0][m][j] + ba), ig = sigmoidf_(acc[1][m][j] + bx);
            const float la = ls8 * r; const float a = __expf(la);
            const float x2 = 2.f * la;
            const float om = -x2 * (1.f + 0.5f * x2 * (1.f + (1.f / 3.f) * x2 * (1.f + 0.25f * x2 * (1.f + 0.2f * x2))));
            const float u = __builtin_amdgcn_sqrtf(fmaxf(om, 0.f)) * (ig * xc);
            acc[0][m][j] = a; acc[1][m][j] = u; }
    float TP = 1.f, TH = 0.f;
    const int q = DIR ? 3 - fq : fq;
#pragma unroll
    for (int mm = 0; mm < 8; ++mm) { const int m = DIR ? 7 - mm : mm;
        float p[4], h[4];
#pragma unroll
        for (int k = 0; k < 4; ++k) { const int j = DIR ? 3 - k : k;
            if (k == 0) { p[j] = acc[0][m][j]; h[j] = acc[1][m][j]; }
            else { const int jp = DIR ? j + 1 : j - 1; p[j] = p[jp] * acc[0][m][j]; h[j] = acc[0][m][j] * h[jp] + acc[1][m][j]; } }
        const float aggP = p[DIR ? 0 : 3], aggH = h[DIR ? 0 : 3];
        float cP = 1.f, cH = 0.f;
#pragma unroll
        for (int k = 0; k < 3; ++k) { const int sfq = DIR ? 3 - k : k;
            const float qP = __shfl(aggP, fr + 16 * sfq), qH = __shfl(aggH, fr + 16 * sfq);
            if (k < q) { cH = qP * cH + qH; cP = cP * qP; } }
        float tP = cP * aggP, tH = aggP * cH + aggH;
        tP = __shfl(tP, fr + 16 * (DIR ? 0 : 3)); tH = __shfl(tH, fr + 16 * (DIR ? 0 : 3));
        const float prefP = TP * cP, prefH = cP * TH + cH;
#pragma unroll
        for (int j = 0; j < 4; ++j) { const int t = 16 * m + 4 * fq + j;
            OP[t * LP + 16 * wv + fr] = (u16)f2bf(prefP * p[j]);
            OH[t * LP + 16 * wv + fr] = (u16)f2bf(p[j] * prefH + h[j]); }
        TH = tP * TH + tH; TP = TP * tP;
    }
    if (fq == 0) { float* ag = ((float*)(F.ws + WS_AGG)) + ((size_t)((DIR * 8 + b) * 16 + c) * 1024 + dch) * 2; ag[0] = TP; ag[1] = TH; }
    __syncthreads();
    {
        const size_t m0 = (size_t)b * SEQ + c * 128; const int ch = F.tid & 15;
#pragma unroll
        for (int k = 0; k < 4; ++k) { const int row = (F.tid >> 4) + 32 * k;
            const u32x4 vh = *(const LAS u32x4*)(OH + row * LP + ch * 8), vp = *(const LAS u32x4*)(OP + row * LP + ch * 8);
            const size_t gi = ((size_t)DIR * M + m0 + row) * 1024 + n * 128 + ch * 8;
            *(u32x4*)(((u16*)(F.ws + WS_HL)) + gi) = vh; *(u32x4*)(((u16*)(F.ws + WS_PP)) + gi) = vp; }
    }
    __syncthreads();
}
__device__ __forceinline__ void lru_unit(Frame& F, int u) {
    const int b = u >> 7, c = (u >> 3) & 15, n = u & 7;
    LAS u16* XC = (LAS u16*)F.lds; LAS u16* OH = XC + 128 * LP; LAS u16* OP = OH + 128 * LP;
    {
        const int cgp = F.tid & 15, rg = F.tid >> 4, wch = n * 128 + cgp * 8, t0 = c * 128 + rg * 4;
        float cw[4][8], cb[8]; u32x4 xw[7];
#pragma unroll
        for (int j = 0; j < 4; ++j) { const f32x4 a = *(const f32x4*)(F.conv_w + j * 1024 + wch), bq = *(const f32x4*)(F.conv_w + j * 1024 + wch + 4);
            cw[j][0] = a.x; cw[j][1] = a.y; cw[j][2] = a.z; cw[j][3] = a.w; cw[j][4] = bq.x; cw[j][5] = bq.y; cw[j][6] = bq.z; cw[j][7] = bq.w; }
        { const f32x4 a = *(const f32x4*)(F.conv_b + wch), bq = *(const f32x4*)(F.conv_b + wch + 4);
            cb[0] = a.x; cb[1] = a.y; cb[2] = a.z; cb[3] = a.w; cb[4] = bq.x; cb[5] = bq.y; cb[6] = bq.z; cb[7] = bq.w; }
#pragma unroll
        for (int rr = 0; rr < 7; ++rr) { const int t = t0 - 2 + rr;
            xw[rr] = (u32x4){0u, 0u, 0u, 0u};
            if (t >= 0 && t < SEQ) xw[rr] = *(const u32x4*)(((u16*)(F.ws + WS_BIG)) + ((size_t)b * SEQ + t) * EVEN_IN + C_XL + wch); }
#pragma unroll
        for (int r = 0; r < 4; ++r) { float o[8];
#pragma unroll
            for (int e = 0; e < 8; ++e) o[e] = cb[e];
#pragma unroll
            for (int j = 0; j < 4; ++j) { const u32x4 w = xw[r + j];
                o[0] += lo16(w.x) * cw[j][0]; o[1] += hi16(w.x) * cw[j][1]; o[2] += lo16(w.y) * cw[j][2]; o[3] += hi16(w.y) * cw[j][3];
                o[4] += lo16(w.z) * cw[j][4]; o[5] += hi16(w.z) * cw[j][5]; o[6] += lo16(w.w) * cw[j][6]; o[7] += hi16(w.w) * cw[j][7]; }
            u32x4 w; w.x = pk2(o[0], o[1]); w.y = pk2(o[2], o[3]); w.z = pk2(o[4], o[5]); w.w = pk2(o[6], o[7]);
            *(LAS u32x4*)(XC + (rg * 4 + r) * LP + cgp * 8) = w; }
    }
    __syncthreads();
    lru_dir<0>(F, b, c, n, XC, OH, OP);
    lru_dir<1>(F, b, c, n, XC, OH, OP);
}

__device__ __forceinline__ void lru_apply_unit(Frame& F, int u) {
    const int b = u >> 6, c = (u >> 2) & 15, q4 = u & 3, w2 = 2 * F.tid;
    LAS float* CF = (LAS float*)F.lds; LAS float* CB = CF + 1024;
    {
        float cf0 = 0.f, cf1 = 0.f, cb0 = 0.f, cb1 = 0.f;
#pragma unroll 8
        for (int k = 0; k < 16; ++k) { const f32x4 a = *(const f32x4*)(((float*)(F.ws + WS_AGG)) + ((size_t)((0 * 8 + b) * 16 + k) * 1024 + w2) * 2);
            if (k < c) { cf0 = a.x * cf0 + a.y; cf1 = a.z * cf1 + a.w; } }
#pragma unroll 8
        for (int k = 15; k >= 0; --k) { const f32x4 a = *(const f32x4*)(((float*)(F.ws + WS_AGG)) + ((size_t)((1 * 8 + b) * 16 + k) * 1024 + w2) * 2);
            if (k > c) { cb0 = a.x * cb0 + a.y; cb1 = a.z * cb1 + a.w; } }
        CF[w2] = cf0; CF[w2 + 1] = cf1; CB[w2] = cb0; CB[w2 + 1] = cb1;
    }
    __syncthreads();
    {
        const int chg = F.tid & 127, rsub = F.tid >> 7;
        float cf[8], cb[8];
        { const f32x4 a0 = *(const LAS f32x4*)(CF + 8 * chg), a1 = *(const LAS f32x4*)(CF + 8 * chg + 4), b0 = *(const LAS f32x4*)(CB + 8 * chg), b1 = *(const LAS f32x4*)(CB + 8 * chg + 4);
            cf[0] = a0.x; cf[1] = a0.y; cf[2] = a0.z; cf[3] = a0.w; cf[4] = a1.x; cf[5] = a1.y; cf[6] = a1.z; cf[7] = a1.w;
            cb[0] = b0.x; cb[1] = b0.y; cb[2] = b0.z; cb[3] = b0.w; cb[4] = b1.x; cb[5] = b1.y; cb[6] = b1.z; cb[7] = b1.w; }
#pragma unroll 4
        for (int i = 0; i < 8; ++i) { const size_t m = (size_t)b * SEQ + c * 128 + q4 * 32 + rsub + 4 * i; const size_t idx = m * 1024 + 8 * chg;
            const u32x4 hf = *(const u32x4*)(((u16*)(F.ws + WS_HL)) + idx), pf = *(const u32x4*)(((u16*)(F.ws + WS_PP)) + idx);
            const u32x4 hb = *(const u32x4*)(((u16*)(F.ws + WS_HL)) + (size_t)M * 1024 + idx), pb = *(const u32x4*)(((u16*)(F.ws + WS_PP)) + (size_t)M * 1024 + idx);
            const u32x4 gl = *(const u32x4*)(((u16*)(F.ws + WS_BIG)) + m * EVEN_IN + C_GL + 8 * chg);
            u32x4 o;
#pragma unroll
            for (int e = 0; e < 4; ++e) {
                const float y0 = lo16(hf[e]) + lo16(pf[e]) * cf[2 * e] + lo16(hb[e]) + lo16(pb[e]) * cb[2 * e];
                const float y1 = hi16(hf[e]) + hi16(pf[e]) * cf[2 * e + 1] + hi16(hb[e]) + hi16(pb[e]) * cb[2 * e + 1];
                o[e] = pg8::cvt_pk_bf16(y0 * siluf_(lo16(gl[e])), y1 * siluf_(hi16(gl[e]))); }
            *(u32x4*)(((u16*)(F.ws + WS_MIX)) + m * DM + 1024 + 8 * chg) = o; }
    }
    __syncthreads();
}
__device__ __forceinline__ void attn_unit(Frame& F, int u) {
    int b = u >> 6, h = (u >> 3) & 7, qb = u & 7;
    if (F.G == 256) { const int x = blockIdx.x & 7, j = (blockIdx.x >> 3) + 32 * (u >> 8); b = x; h = j >> 3; qb = j & 7; }
    const int kvh = h >> 2;
    const size_t row0 = (size_t)b * SEQ + qb * 256, rowb = (size_t)b * SEQ;
    att::attn_dense_body<att::bf16>((const att::bf16*)(((u16*)(F.ws + WS_BIG)) + row0 * EVEN_IN + C_Q + h * 128), (const att::bf16*)(((u16*)(F.ws + WS_BIG)) + rowb * EVEN_IN + C_K + kvh * 128),
                                    (const att::bf16*)(((u16*)(F.ws + WS_BIG)) + rowb * EVEN_IN + C_V + kvh * 128), ((u16*)(F.ws + WS_MIX)) + row0 * DM + h * 128,
                                    ((u16*)(F.ws + WS_BIG)) + row0 * EVEN_IN + C_GA + h * 128, SEQ, F.lds_g);
    __syncthreads();
}

__device__ __forceinline__ void gates_finish(Frame& F, int r0, f32x4 a0, f32x4 a1) {
    const int fr = F.lane & 15, fq = F.lane >> 4;
    const float bi0 = F.gate_bias[fr], bi1 = F.gate_bias[16 + fr];
#pragma unroll
    for (int j = 0; j < 4; ++j) { float* g = ((float*)(F.ws + WS_GATES)) + (size_t)(r0 + 4 * fq + j) * 32;
        const float rsc = rsqrtf(((const float*)(F.ws + WS_SUMSQ))[r0 + 4 * fq + j] * (1.f / 2048.f) + EPS);
        g[fr] = a0[j] * rsc + bi0; g[16 + fr] = logsigf_(a1[j] * rsc + bi1); }
}
__device__ __forceinline__ void gates_partial(Frame& F, int r0, int kk0, int nkk, f32x4& a0, f32x4& a1) {
    const int lane = F.lane, fr = lane & 15, fq = lane >> 4;
    a0 = (f32x4){0.f, 0.f, 0.f, 0.f}; a1 = a0;
    const u16* ap = ((u16*)(F.ws + WS_XN)) + (size_t)(r0 + fr) * DM + fq * 8 + kk0 * 32; const u16* bp0 = ((u16*)(F.ws + WS_WG1T)) + (size_t)fr * DM + fq * 8 + kk0 * 32; const u16* bp1 = bp0 + 16 * DM;
#pragma unroll 8
    for (int kk = 0; kk < nkk; ++kk) { const bf16x8 a = *(const bf16x8*)(ap + kk * 32);
        a0 = MFMA16(a, *(const bf16x8*)(bp0 + kk * 32), a0); a1 = MFMA16(a, *(const bf16x8*)(bp1 + kk * 32), a1); }
}
__device__ __forceinline__ void gates_task(Frame& F, int task) { f32x4 a0, a1; gates_partial(F, task * 16, 0, 64, a0, a1); gates_finish(F, task * 16, a0, a1); }
constexpr int GWP = 2056;
__device__ __forceinline__ void gates_phase_split(Frame& F) {
    LAS u16* Bs = (LAS u16*)F.lds;
    for (int i = F.tid; i < 32 * 256; i += NWAVES * 64) { const int row = i >> 8, ch = i & 255;
        *(LAS u32x4*)(Bs + row * GWP + ch * 8) = *(const u32x4*)(((u16*)(F.ws + WS_WG1T)) + (size_t)row * DM + ch * 8); }
    __syncthreads();
    const int task = F.gw >> 1, half = F.wave & 1, lane = F.lane, fr = lane & 15, fq = lane >> 4, r0 = task * 16;
    f32x4 a0 = (f32x4){0.f, 0.f, 0.f, 0.f}, a1 = a0;
    const u16* ap = ((u16*)(F.ws + WS_XN)) + (size_t)(r0 + fr) * DM + fq * 8 + half * 1024;
    const LAS u16* bp0 = Bs + fr * GWP + fq * 8 + half * 1024; const LAS u16* bp1 = bp0 + 16 * GWP;
#pragma unroll
    for (int kb = 0; kb < 2; ++kb) { bf16x8 av[16];
#pragma unroll
        for (int kk = 0; kk < 16; ++kk) av[kk] = *(const bf16x8*)(ap + (kb * 16 + kk) * 32);
#pragma unroll
        for (int kk = 0; kk < 16; ++kk) { a0 = MFMA16(av[kk], *(const LAS bf16x8*)(bp0 + (kb * 16 + kk) * 32), a0); a1 = MFMA16(av[kk], *(const LAS bf16x8*)(bp1 + (kb * 16 + kk) * 32), a1); } }
    __syncthreads();
    LAS f32x4* X = (LAS f32x4*)F.lds + (F.wave >> 1) * 128 + lane;
    if (half) { X[0] = a0; X[64] = a1; }
    __syncthreads();
    if (!half) { a0 = a0 + X[0]; a1 = a1 + X[64]; gates_finish(F, r0, a0, a1); }
}

__device__ __forceinline__ void mlstm_unit(Frame& F, int u, u16* Hout) {
    const int b = u >> 5, h = (u >> 2) & 7, dir = (u >> 1) & 1, vh = u & 1;
    const int tid = F.tid, wv = tid >> 6, lane = F.lane, fr = lane & 15, fq = lane >> 4;
    const int rg = wv >> 1, ch = wv & 1;
    LAS u16* Ks = (LAS u16*)F.lds; LAS u16* Ktw = Ks + 128 * LP; LAS u16* Vt = Ktw + 128 * LP; LAS u16* Cb = Vt + 128 * LP;
    LAS float* Gs = (LAS float*)(Cb + 144 * LP); LAS float* MMs = Gs + 128; LAS float* MTs = MMs + 128; LAS float* Ns = MTs + 128; LAS float* SCs = Ns + 128; LAS float* RSs = SCs + 16;
    for (int i = tid; i < 144 * LP / 2; i += NWAVES * 64) ((LAS unsigned*)Cb)[i] = 0u;
    if (tid < 128) Ns[tid] = 0.f;
    f32x4 Cacc[2][4];
#pragma unroll
    for (int mt = 0; mt < 2; ++mt)
#pragma unroll
        for (int nt = 0; nt < 4; ++nt) Cacc[mt][nt] = (f32x4){0.f, 0.f, 0.f, 0.f};
    float mstate = 0.f;
    const u16* P1 = ((u16*)(F.ws + WS_BIG));
#define GROWC(cc, i) ((size_t)b * SEQ + (size_t)(dir ? (SEQ - 1 - (128 * (cc) + (i))) : (128 * (cc) + (i))))
#define GROW(i) GROWC(c, i)
    const int r0 = 2 * lane, r1 = 2 * lane + 1;
    bf16x8 kA[2], kB[2], vA[2], vB[2];
    float gi0 = 0.f, gi1 = 0.f, gf0 = 0.f, gf1 = 0.f;
#define MLOAD(cc) do { const size_t g0_ = GROWC(cc, r0), g1_ = GROWC(cc, r1); \
        _Pragma("unroll") for (int k = 0; k < 2; ++k) { const int col = (wv + 8 * k) * 8; \
            kA[k] = *(const bf16x8*)(P1 + g0_ * ODD_MAIN + D_K + h * 128 + col); kB[k] = *(const bf16x8*)(P1 + g1_ * ODD_MAIN + D_K + h * 128 + col); \
            vA[k] = *(const bf16x8*)(P1 + g0_ * ODD_MAIN + D_V + h * 256 + vh * 128 + col); vB[k] = *(const bf16x8*)(P1 + g1_ * ODD_MAIN + D_V + h * 256 + vh * 128 + col); } \
        if (wv == 0) { const float* G0 = ((float*)(F.ws + WS_GATES)) + g0_ * 32; const float* G1 = ((float*)(F.ws + WS_GATES)) + g1_ * 32; \
            gi0 = G0[dir * 8 + h]; gi1 = G1[dir * 8 + h]; gf0 = G0[16 + dir * 8 + h]; gf1 = G1[16 + dir * 8 + h]; } } while (0)
    MLOAD(0);
    for (int c = 0; c < 16; ++c) {
        bf16x8 Qf[2][4];
#pragma unroll
        for (int mt = 0; mt < 2; ++mt) { const size_t gq_ = GROW(32 * rg + 16 * mt + fr);
#pragma unroll
            for (int kk = 0; kk < 4; ++kk) Qf[mt][kk] = *(const bf16x8*)(P1 + gq_ * ODD_MAIN + D_Q + h * 128 + kk * 32 + fq * 8); }
        if (wv == 0) {
            const float i0 = gi0, i1 = gi1, f0 = gf0, f1 = gf1;
            const float s = f0 + f1; float incl = s;
#pragma unroll
            for (int o = 1; o < 64; o <<= 1) { const float t = __shfl_up(incl, o); if (lane >= o) incl += t; }
            const float b0 = incl - s + f0, b1 = incl;
            const float gg0 = i0 - b0, gg1 = i1 - b1;
            float inclm = fmaxf(gg0, gg1);
#pragma unroll
            for (int o = 1; o < 64; o <<= 1) { const float t = __shfl_up(inclm, o); if (lane >= o) inclm = fmaxf(inclm, t); }
            float exclm = __shfl_up(inclm, 1); if (lane == 0) exclm = -INFINITY;
            const float cm0 = fmaxf(exclm, gg0), cm1 = fmaxf(cm0, gg1);
            const float M0 = fmaxf(mstate, cm0), M1 = fmaxf(mstate, cm1);
            Gs[r0] = gg0; Gs[r1] = gg1; MMs[r0] = M0; MMs[r1] = M1; MTs[r0] = b0 + M0; MTs[r1] = b1 + M1;
            const float blast = __shfl(b1, 63), M127 = __shfl(M1, 63);
            if (lane == 0) { SCs[0] = mstate; SCs[1] = M127; }
            mstate = blast + M127;
        }
        __syncthreads();
        const float mold = SCs[0], M127 = SCs[1];
        const float decay = __expf(mold - M127);
        {   const float ws0 = __expf(Gs[r0] - M127), ws1 = __expf(Gs[r1] - M127);
#pragma unroll
            for (int k = 0; k < 2; ++k) { const int col = (wv + 8 * k) * 8;
                *(LAS bf16x8*)(Ks + r0 * LP + col) = kA[k]; *(LAS bf16x8*)(Ks + r1 * LP + col) = kB[k];
#pragma unroll
                for (int e = 0; e < 8; ++e) {
                    const float ka = bf2f((u16)kA[k][e]) * ws0, kb = bf2f((u16)kB[k][e]) * ws1;
                    ((LAS unsigned*)(Ktw + (col + e) * LP))[lane] = pg8::cvt_pk_bf16(ka, kb);
                    ((LAS unsigned*)(Vt + (col + e) * LP))[lane] = (unsigned)(u16)vA[k][e] | ((unsigned)(u16)vB[k][e] << 16); } }
        }
        { const int cn = c < 15 ? c + 1 : 15; MLOAD(cn); }
        __syncthreads();
        f32x4 S[2][4], N[2][4], N8[2];
#pragma unroll
        for (int mt = 0; mt < 2; ++mt) { N8[mt] = (f32x4){0.f, 0.f, 0.f, 0.f};
#pragma unroll
            for (int nt = 0; nt < 4; ++nt) { S[mt][nt] = (f32x4){0.f, 0.f, 0.f, 0.f}; N[mt][nt] = (f32x4){0.f, 0.f, 0.f, 0.f}; } }
#pragma unroll
        for (int nt = 0; nt < 4; ++nt)
#pragma unroll
            for (int kk = 0; kk < 4; ++kk) {
                const bf16x8 kf = *(const LAS bf16x8*)(Ks + (64 * ch + 16 * nt + fr) * LP + kk * 32 + fq * 8);
                const bf16x8 cf = *(const LAS bf16x8*)(Cb + (64 * ch + 16 * nt + fr) * LP + kk * 32 + fq * 8);
#pragma unroll
                for (int mt = 0; mt < 2; ++mt) { S[mt][nt] = MFMA16(kf, Qf[mt][kk], S[mt][nt]);
                    N[mt][nt] = MFMA16(cf, Qf[mt][kk], N[mt][nt]); } }
#pragma unroll
        for (int kk = 0; kk < 4; ++kk) { const bf16x8 nf = *(const LAS bf16x8*)(Cb + (128 + fr) * LP + kk * 32 + fq * 8);
#pragma unroll
            for (int mt = 0; mt < 2; ++mt) N8[mt] = MFMA16(nf, Qf[mt][kk], N8[mt]); }
        float Ml[2], inter[2], qn[2], rs[2];
#pragma unroll
        for (int mt = 0; mt < 2; ++mt) { const int l = 32 * rg + 16 * mt + fr; Ml[mt] = MMs[l]; inter[mt] = __expf(mold - Ml[mt]); qn[mt] = __shfl(N8[mt][0], fr); rs[mt] = 0.f; }
#pragma unroll
        for (int nt = 0; nt < 4; ++nt) { const f32x4 g4 = *(const LAS f32x4*)(Gs + 64 * ch + 16 * nt + 4 * fq);
#pragma unroll
            for (int mt = 0; mt < 2; ++mt) { const int l = 32 * rg + 16 * mt + fr;
#pragma unroll
                for (int j = 0; j < 4; ++j) { const int sidx = 64 * ch + 16 * nt + 4 * fq + j;
                    const float dm = (sidx <= l) ? __expf(g4[j] - Ml[mt]) : 0.f; const float sc = S[mt][nt][j] * dm; S[mt][nt][j] = sc; rs[mt] += sc; } } }
#pragma unroll
        for (int mt = 0; mt < 2; ++mt) { rs[mt] += __shfl_xor(rs[mt], 16); rs[mt] += __shfl_xor(rs[mt], 32);
            if (fq == 0) RSs[(32 * rg + 16 * mt + fr) * 2 + ch] = rs[mt]; }
        __syncthreads();
#pragma unroll
        for (int mt = 0; mt < 2; ++mt)
#pragma unroll
            for (int nt = 0; nt < 4; ++nt) { u32x2 w; w.x = pg8::cvt_pk_bf16(S[mt][nt][0], S[mt][nt][1]); w.y = pg8::cvt_pk_bf16(S[mt][nt][2], S[mt][nt][3]);
                *(LAS u32x2*)(Ks + (32 * rg + 16 * mt + fr) * LP + 64 * ch + 16 * nt + 4 * fq) = w; }
        __syncthreads();
#pragma unroll
        for (int mt = 0; mt < 2; ++mt)
#pragma unroll
            for (int nt = 0; nt < 4; ++nt) N[mt][nt] = N[mt][nt] * inter[mt];
        {   bf16x8 Af[2][4];
#pragma unroll
            for (int mt = 0; mt < 2; ++mt)
#pragma unroll
                for (int kk = 0; kk < 4; ++kk) Af[mt][kk] = *(const LAS bf16x8*)(Ks + (32 * rg + 16 * mt + fr) * LP + kk * 32 + fq * 8);
#pragma unroll
            for (int nt = 0; nt < 4; ++nt)
#pragma unroll
                for (int kk = 0; kk < 4; ++kk) { const bf16x8 vf = *(const LAS bf16x8*)(Vt + (64 * ch + 16 * nt + fr) * LP + kk * 32 + fq * 8);
#pragma unroll
                    for (int mt = 0; mt < 2; ++mt) N[mt][nt] = MFMA16(vf, Af[mt][kk], N[mt][nt]); }
        }
#pragma unroll
        for (int mt = 0; mt < 2; ++mt) { const int l = 32 * rg + 16 * mt + fr;
            const float den = RSs[2 * l] + RSs[2 * l + 1] + inter[mt] * qn[mt];
            const float inv = __builtin_amdgcn_rcpf(fmaxf(fabsf(den), __expf(-MTs[l])));
            u16* orow = Hout + GROW(l) * DM + h * 256 + vh * 128 + 64 * ch + 4 * fq;
#pragma unroll
            for (int nt = 0; nt < 4; ++nt) { u32x2 w; w.x = pg8::cvt_pk_bf16(N[mt][nt][0] * inv, N[mt][nt][1] * inv); w.y = pg8::cvt_pk_bf16(N[mt][nt][2] * inv, N[mt][nt][3] * inv);
                *(u32x2*)(orow + 16 * nt) = w; } }
#pragma unroll
        for (int mt = 0; mt < 2; ++mt)
#pragma unroll
            for (int nt = 0; nt < 4; ++nt) Cacc[mt][nt] = Cacc[mt][nt] * decay;
        {   bf16x8 Vf[2][4];
#pragma unroll
            for (int mt = 0; mt < 2; ++mt)
#pragma unroll
                for (int kk = 0; kk < 4; ++kk) Vf[mt][kk] = *(const LAS bf16x8*)(Vt + (32 * rg + 16 * mt + fr) * LP + kk * 32 + fq * 8);
#pragma unroll
            for (int nt = 0; nt < 4; ++nt)
#pragma unroll
                for (int kk = 0; kk < 4; ++kk) { const bf16x8 kf = *(const LAS bf16x8*)(Ktw + (64 * ch + 16 * nt + fr) * LP + kk * 32 + fq * 8);
#pragma unroll
                    for (int mt = 0; mt < 2; ++mt) Cacc[mt][nt] = MFMA16(kf, Vf[mt][kk], Cacc[mt][nt]); }
        }
        float nnew = 0.f;
        if (tid < 128) { float sum = 0.f;
#pragma unroll
            for (int s8 = 0; s8 < 16; ++s8) { const u32x4 w = *(const LAS u32x4*)(Ktw + tid * LP + s8 * 8);
                sum += (lo16(w.x) + hi16(w.x)) + (lo16(w.y) + hi16(w.y)) + (lo16(w.z) + hi16(w.z)) + (lo16(w.w) + hi16(w.w)); }
            nnew = decay * Ns[tid] + sum; }
        __syncthreads();
#pragma unroll
        for (int mt = 0; mt < 2; ++mt)
#pragma unroll
            for (int nt = 0; nt < 4; ++nt) { u32x2 w; w.x = pg8::cvt_pk_bf16(Cacc[mt][nt][0], Cacc[mt][nt][1]); w.y = pg8::cvt_pk_bf16(Cacc[mt][nt][2], Cacc[mt][nt][3]);
                *(LAS u32x2*)(Cb + (32 * rg + 16 * mt + fr) * LP + 64 * ch + 16 * nt + 4 * fq) = w; }
        if (tid < 128) { Ns[tid] = nnew; Cb[128 * LP + tid] = (u16)f2bf(nnew); }
    }
#undef GROW
#undef GROWC
#undef MLOAD
    __syncthreads();
}

__device__ __forceinline__ void combine_token(Frame& F, int m, const u16* HF, const u16* HBMIX, u16* DST, size_t didx_mask) {
    const int lane = F.lane, half = lane >> 5, i8 = (lane & 31) * 8;
    const size_t idx = (size_t)m * DM + half * 256 + i8; const u16* pz = ((u16*)(F.ws + WS_BIG)) + (size_t)m * ODD_MAIN + half * 256 + i8;
    u32x4 hf[4], hb[4], ov[4], zv[4];
#pragma unroll
    for (int hp = 0; hp < 4; ++hp) { hf[hp] = *(const u32x4*)(HF + idx + hp * 512); hb[hp] = *(const u32x4*)(HBMIX + idx + hp * 512);
        ov[hp] = *(const u32x4*)(pz + D_O + hp * 512); zv[hp] = *(const u32x4*)(pz + D_Z + hp * 512); }
#pragma unroll
    for (int hp = 0; hp < 4; ++hp) {
        const f32x4 g0 = *(const f32x4*)(F.norm1 + hp * 512 + half * 256 + i8), g1 = *(const f32x4*)(F.norm1 + hp * 512 + half * 256 + i8 + 4);
        float v[8]; float ss = 0.f;
#pragma unroll
        for (int e = 0; e < 4; ++e) { v[2 * e] = sigmoidf_(lo16(ov[hp][e])) * (lo16(hf[hp][e]) + lo16(hb[hp][e])); v[2 * e + 1] = sigmoidf_(hi16(ov[hp][e])) * (hi16(hf[hp][e]) + hi16(hb[hp][e]));
            ss += v[2 * e] * v[2 * e] + v[2 * e + 1] * v[2 * e + 1]; }
#pragma unroll
        for (int o = 1; o < 32; o <<= 1) ss += __shfl_xor(ss, o);
        const float r = rsqrtf(ss * (1.f / 256.f) + EPS);
        u32x4 o;
        o[0] = pg8::cvt_pk_bf16(v[0] * r * g0.x * siluf_(lo16(zv[hp][0])), v[1] * r * g0.y * siluf_(hi16(zv[hp][0])));
        o[1] = pg8::cvt_pk_bf16(v[2] * r * g0.z * siluf_(lo16(zv[hp][1])), v[3] * r * g0.w * siluf_(hi16(zv[hp][1])));
        o[2] = pg8::cvt_pk_bf16(v[4] * r * g1.x * siluf_(lo16(zv[hp][2])), v[5] * r * g1.y * siluf_(hi16(zv[hp][2])));
        o[3] = pg8::cvt_pk_bf16(v[6] * r * g1.z * siluf_(lo16(zv[hp][3])), v[7] * r * g1.w * siluf_(hi16(zv[hp][3])));
        *(u32x4*)(DST + ((idx + hp * 512) & didx_mask)) = o; }
}
__device__ __forceinline__ void final_row(const u16* row, float ss, float* drow, const float* gain, int lane) {
    const unsigned long long* xr = (const unsigned long long*)row + lane; f32x4* dr = (f32x4*)drow + lane; const f32x4* gr = (const f32x4*)gain + lane;
    const float r = rsqrtf(ss * (1.f / DM) + EPS);
    unsigned long long w[8];
#pragma unroll
    for (int j = 0; j < 8; ++j) w[j] = xr[64 * j];
#pragma unroll
    for (int j = 0; j < 8; ++j) { const f32x4 g = gr[64 * j]; const unsigned lo = (unsigned)w[j], hi = (unsigned)(w[j] >> 32);
        dr[64 * j] = (f32x4){lo16(lo) * r * g.x, hi16(lo) * r * g.y, lo16(hi) * r * g.z, hi16(hi) * r * g.w}; }
}

#define XB_TMO      128
#define XB_XCNT(j)  (256  + 64 * (j))
#define XB_XSUB(j)  (1280 + 64 * (j))
#define XB_XGEN(j)  (2304 + 64 * (j))
#define XB_TOP      3328
#define XB_TOPGEN   3392
#define XCD_BAR_WORDS 3456
#define XB_SPIN_CAP (1u << 18)

__device__ __forceinline__ unsigned xb_ld(unsigned* p)              { return __hip_atomic_load(p, __ATOMIC_RELAXED, __HIP_MEMORY_SCOPE_AGENT); }
__device__ __forceinline__ unsigned xb_add(unsigned* p, unsigned v) { return __hip_atomic_fetch_add(p, v, __ATOMIC_RELAXED, __HIP_MEMORY_SCOPE_AGENT); }
__device__ __forceinline__ unsigned xb_xcc_id() { return (unsigned)__builtin_amdgcn_s_getreg((3 << 11) | 20) & 0xFu; }
#define XB_SPIN(cond, bar) do { unsigned _sp = 0; while (cond) { __builtin_amdgcn_s_sleep(1); \
    if ((++_sp & 255u) == 0u) { if (xb_ld(&(bar)[XB_TMO])) break; if (_sp > XB_SPIN_CAP) { atomicAdd(&(bar)[XB_TMO], 1u); break; } } } } while (0)

struct XcdBarrier {
    unsigned* bar; unsigned x;
    volatile LAS unsigned* st;
};

__device__ __forceinline__ XcdBarrier xcd_barrier_post(unsigned* bar, volatile LAS unsigned* st) {
    XcdBarrier b; b.bar = bar; b.x = xb_xcc_id(); b.st = st;
    if (threadIdx.x == 0) (void)xb_add(&bar[XB_XCNT(b.x)], 1u);
    return b;
}
__device__ __forceinline__ void xcd_barrier_complete(unsigned* bar, unsigned x, unsigned& nloc, unsigned& nx) {
    const unsigned G = gridDim.x * gridDim.y * gridDim.z;
    unsigned sum, cnt, mine, sp = 0u;
    for (;;) {
        sum = 0u; cnt = 0u; mine = 0u;
#pragma unroll
        for (unsigned j = 0; j < 16; ++j) { const unsigned c = xb_ld(&bar[XB_XCNT(j)]); sum += c; cnt += (c > 0u) ? 1u : 0u; mine = (j == x) ? c : mine; }
        if (sum == G) break;
        __builtin_amdgcn_s_sleep(1);
        if ((++sp & 255u) == 0u) { if (xb_ld(&bar[XB_TMO])) break; if (sp > XB_SPIN_CAP) { atomicAdd(&bar[XB_TMO], 1u); break; } }
    }
    nloc = mine > 0u ? mine : 1u; nx = cnt > 0u ? cnt : 1u;
}

__device__ __forceinline__ void xcd_barrier(const XcdBarrier& b) {
    asm volatile("s_waitcnt vmcnt(0)" ::: "memory");
    __syncthreads();
    if (threadIdx.x == 0) {
        unsigned* bar = b.bar;
        __builtin_amdgcn_s_waitcnt(0);
        unsigned nloc = b.st[0], nx = b.st[1];
        if (nloc == 0u) { xcd_barrier_complete(bar, b.x, nloc, nx); b.st[0] = nloc; b.st[1] = nx; }
        const unsigned old = xb_add(&bar[XB_XSUB(b.x)], 1u);
        const unsigned gen = old / nloc;
        if (old + 1u == (gen + 1u) * nloc) {
            __builtin_amdgcn_fence(__ATOMIC_RELEASE, "agent");
            asm volatile("s_waitcnt vmcnt(0)" ::: "memory");
            const unsigned og = xb_add(&bar[XB_TOP], 1u);
            const unsigned tg = og / nx;
            if (og + 1u == (tg + 1u) * nx) xb_add(&bar[XB_TOPGEN], 1u);
            else XB_SPIN(xb_ld(&bar[XB_TOPGEN]) == tg, bar);
            __builtin_amdgcn_fence(__ATOMIC_ACQUIRE, "agent");
            xb_add(&bar[XB_XGEN(b.x)], 1u);
            asm volatile("s_waitcnt vmcnt(0)" ::: "memory");
        } else {
            XB_SPIN(xb_ld(&bar[XB_XGEN(b.x)]) == gen, bar);
            __builtin_amdgcn_fence(__ATOMIC_ACQUIRE, "agent");
            asm volatile("s_waitcnt vmcnt(0)" ::: "memory");
        }
    }
    __syncthreads();
}
__global__ void __launch_bounds__(NWAVES * 64, 2) fwd_megakernel(Args args) {
    extern __shared__ __attribute__((aligned(16))) unsigned char lds[];
    cg::grid_group grid = cg::this_grid();
    Frame F;
    F.lds = (LAS unsigned char*)lds; F.lds_g = (char*)lds;
    F.tid = threadIdx.x; F.lane = F.tid & 63; F.wave = __builtin_amdgcn_readfirstlane(F.tid >> 6);
    F.G = gridDim.x; F.gw = blockIdx.x * NWAVES + F.wave; F.NGW = F.G * NWAVES;
    F.x = args.in[0]; F.norm_gain = args.in[1]; F.final_gain = args.in[2]; F.w_in0 = args.in[3]; F.w_out0 = args.in[4]; F.qg = args.in[5]; F.kg = args.in[6];
    F.conv_w = args.in[7]; F.conv_b = args.in[8]; F.lru_wa = args.in[9]; F.lru_ba = args.in[10]; F.lru_wx = args.in[11]; F.lru_bx = args.in[12]; F.lru_lam = args.in[13];
    F.w_in1 = args.in[14]; F.gate_bias = args.in[15]; F.norm1 = args.in[16]; F.w_out1 = args.in[17]; F.out = args.out; F.ws = args.ws;
    const int lo = args.ph_lo, hi = args.ph_hi;
    if (F.tid < 16) ((LAS unsigned*)(F.lds + LDS_MISC))[F.tid] = 0u;
    __syncthreads();
    const XcdBarrier xbar = xcd_barrier_post((unsigned*)(args.ws + WS_CTL), (volatile LAS unsigned*)(F.lds + LDS_MISC));
#ifndef PH_MASK
#define PH_MASK 0x7ff
#endif
#define IN(k) ((((PH_MASK) >> (k)) & 1) && lo <= (k) && (k) < hi)
#ifndef XTRA_XB
#define XTRA_XB 0
#endif
#define SEAM(k) do { if (IN(k) && IN((k) + 1)) { xcd_barrier(xbar); if ((k) == 4) for (int xx_ = 0; xx_ < XTRA_XB; ++xx_) xcd_barrier(xbar); } } while (0)
#ifndef DUP_MASK
#define DUP_MASK 0
#endif
#ifndef EXTRA_SYNCS
#define EXTRA_SYNCS 0
#endif
#define REPS(k) for (int rep_ = 0; rep_ < 1 + (((DUP_MASK) >> (k)) & 1); ++rep_)
#define REPSYNC() do { if (rep_) xcd_barrier(xbar); } while (0)
    for (int es_ = (lo < 0 ? -1 : 0); es_ < EXTRA_SYNCS; ++es_) grid.sync();

    if (IN(0)) REPS(0) { REPSYNC(); p0_prologue(F); __syncthreads(); }
    SEAM(0);
    if (IN(1)) {
        pg8::Gemm g{((u16*)(F.ws + WS_XN)), ((u16*)(F.ws + WS_W0T)), M, EVEN_IN, DM}; pg8::StaticOrder S; S.init(M, EVEN_IN, F.G, (int)blockIdx.x);
        pg8::EpiBf16S E{((u16*)(F.ws + WS_BIG)), EVEN_IN, 0, 0, 1.f, nullptr};
        pg8::gemm_phase<pg8::EpiBf16S, pg8::StaticOrder, true, PG8_SP2>(F.lds, g, S, E);
        if (F.G == 256 && blockIdx.x >= 128) { __syncthreads(); p1_deferred(F); __syncthreads(); }
    }
    SEAM(1);
    if (IN(2)) {
        qk_norm_rope(F);
        for (int u = blockIdx.x; u < 1024; u += F.G) lru_unit(F, u);
    }
    SEAM(2);
    if (IN(3)) {
        REPS(3) { REPSYNC(); for (int u = blockIdx.x; u < 512; u += F.G) attn_unit(F, u); }
        REPS(11) { REPSYNC(); for (int u = blockIdx.x; u < 512; u += F.G) lru_apply_unit(F, u); }
        __syncthreads();
    }
    SEAM(3);
    if (IN(4)) REPS(4) { REPSYNC();
        pg8::Gemm g{((u16*)(F.ws + WS_MIX)), ((u16*)(F.ws + WS_WO0T)), M, DM, DM}; pg8::StaticOrder S; S.init(M, DM, F.G, (int)blockIdx.x);
        pg8::EpiResNormB E{((u16*)(F.ws + WS_XN)), DM, F.norm_gain, F.norm_gain + DM, (const float*)(F.ws + WS_SUMSQ) + 3 * M, (float*)(F.ws + WS_SUMSQ)};
        pg8::gemm_phase<pg8::EpiResNormB, pg8::StaticOrder, true, PG8_SP2>(F.lds, g, S, E);
    }
    SEAM(4);
    if (IN(6) && (((DUP_MASK) >> 12) & 1)) {
        pg8::Gemm g{((u16*)(F.ws + WS_XN)), ((u16*)(F.ws + WS_W1T)), M, ODD_MAIN, DM}; pg8::StaticOrder S; S.init(M, ODD_MAIN, F.G, (int)blockIdx.x);
        pg8::EpiBf16S E{((u16*)(F.ws + WS_BIG)), ODD_MAIN, 4, 8, 0.088388347648318440f, (const float*)(F.ws + WS_SUMSQ)};
        pg8::gemm_phase<pg8::EpiBf16S, pg8::StaticOrder, true, PG8_SP2>(F.lds, g, S, E);
        xcd_barrier(xbar);
    }
    if (IN(4) && (((DUP_MASK) >> 13) & 1)) {
        pg8::Gemm g{((u16*)(F.ws + WS_MIX)), ((u16*)(F.ws + WS_WO0T)), M, DM, DM}; pg8::StaticOrder S; S.init(M, DM, F.G, (int)blockIdx.x);
        pg8::EpiResNorm E{F.x, nullptr, DM, F.norm_gain + DM, ((u16*)(F.ws + WS_XN)), (float*)(F.ws + WS_SUMSQ) + 2 * M};
        pg8::gemm_phase<pg8::EpiResNorm, pg8::StaticOrder, true, PG8_SP2>(F.lds, g, S, E);
        xcd_barrier(xbar);
    }
    if (IN(6)) REPS(6) { REPSYNC();
        if (F.G == 256) gates_phase_split(F); else for (int t = F.gw; t < M / 16; t += F.NGW) gates_task(F, t);
        __syncthreads();
        pg8::Gemm g{((u16*)(F.ws + WS_XN)), ((u16*)(F.ws + WS_W1T)), M, ODD_MAIN, DM}; pg8::StaticOrder S; S.init(M, ODD_MAIN, F.G, (int)blockIdx.x);
        pg8::EpiBf16S E{((u16*)(F.ws + WS_BIG)), ODD_MAIN, 4, 8, 0.088388347648318440f, (const float*)(F.ws + WS_SUMSQ)};
        pg8::gemm_phase<pg8::EpiBf16S, pg8::StaticOrder, true, PG8_SP2>(F.lds, g, S, E);
    }
    SEAM(6);
    if (IN(7)) REPS(7) { REPSYNC(); for (int u = blockIdx.x; u < 256; u += F.G) { const int dir = (u >> 1) & 1; mlstm_unit(F, u, dir ? ((u16*)(F.ws + WS_MIX)) : (u16*)F.out); } }
    SEAM(7);
    if (IN(8) && ((DUP_MASK) >> 8) & 1) { for (int m = F.gw; m < M; m += F.NGW) combine_token(F, m, (const u16*)F.out, ((u16*)(F.ws + WS_MIX)), ((u16*)(F.ws + WS_W0T)), (size_t)(16 * MiB - 1)); xcd_barrier(xbar); }
    if (IN(8)) { for (int m = F.gw; m < M; m += F.NGW) combine_token(F, m, (const u16*)F.out, ((u16*)(F.ws + WS_MIX)), ((u16*)(F.ws + WS_MIX)), ~(size_t)0); }
    SEAM(8);
    if (IN(9)) {
        pg8::Gemm g{((u16*)(F.ws + WS_MIX)), ((u16*)(F.ws + WS_WO1T)), M, DM, DM}; pg8::StaticOrder S; S.init(M, DM, F.G, (int)blockIdx.x);
        pg8::EpiResBf16G E{((u16*)(F.ws + WS_XN)), DM, F.norm_gain + DM, (float*)(F.ws + WS_SUMSQ) + M};
        pg8::gemm_phase<pg8::EpiResBf16G, pg8::StaticOrder, true, PG8_SP2>(F.lds, g, S, E);
    }
    SEAM(9);
    if (IN(10) && ((DUP_MASK) >> 10) & 1) { for (int m = F.gw; m < M; m += F.NGW) final_row(((u16*)(F.ws + WS_XN)) + (size_t)m * DM, ((const float*)(F.ws + WS_SUMSQ))[M + m], ((float*)(F.ws + WS_BIG)) + (size_t)m * DM, F.final_gain, F.lane); xcd_barrier(xbar); }
    if (IN(10)) { for (int m = F.gw; m < M; m += F.NGW) final_row(((u16*)(F.ws + WS_XN)) + (size_t)m * DM, ((const float*)(F.ws + WS_SUMSQ))[M + m], F.out + (size_t)m * DM, F.final_gain, F.lane); }
#undef IN
#undef SEAM
}

#ifndef MK_PER_PHASE
#define MK_PER_PHASE 0
#endif
extern "C" void kernel_launch(void* const* d_in, const int* in_sizes, int n_in, void* d_out, int out_size, void* d_ws, size_t ws_size, hipStream_t stream) {
    static int grid = 0;
    if (grid == 0) {
        if (n_in != 18 || in_sizes[0] != M * DM || out_size != M * DM || ws_size < WS_TOTAL) {
            fprintf(stderr, "kernel_launch: unexpected shapes: n_in %d in0 %d out %d ws %zu (need %zu)\n", n_in, n_in > 0 ? in_sizes[0] : -1, out_size, ws_size, (size_t)WS_TOTAL); grid = -1; return; }
        int dev = 0, cus = 0, per_cu = 0;
        if (hipGetDevice(&dev) != hipSuccess || hipDeviceGetAttribute(&cus, hipDeviceAttributeMultiprocessorCount, dev) != hipSuccess) { grid = -1; return; }
        if (hipFuncSetAttribute((const void*)fwd_megakernel, hipFuncAttributeMaxDynamicSharedMemorySize, LDS_BYTES) != hipSuccess) { fprintf(stderr, "kernel_launch: hipFuncSetAttribute failed\n"); grid = -1; return; }
        if (hipOccupancyMaxActiveBlocksPerMultiprocessor(&per_cu, (const void*)fwd_megakernel, NWAVES * 64, LDS_BYTES) != hipSuccess || per_cu < 1) { fprintf(stderr, "kernel_launch: occupancy query failed (%d)\n", per_cu); grid = -1; return; }
        grid = cus * per_cu;
    }
    if (grid < 0) return;
    if (hipMemsetAsync((char*)d_ws + WS_CTL, 0, CTL_BYTES, stream) != hipSuccess) { fprintf(stderr, "kernel_launch: memset failed\n"); return; }
    Args a{};
    for (int i = 0; i < 18; ++i) a.in[i] = (const float*)d_in[i];
    a.out = (float*)d_out; a.ws = (unsigned char*)d_ws;
#if MK_PER_PHASE
    for (int p = 0; p < NPHASES; ++p) { a.ph_lo = p; a.ph_hi = p + 1; void* kargs[] = {&a};
        hipError_t e = hipLaunchCooperativeKernel((void*)fwd_megakernel, dim3(grid), dim3(NWAVES * 64), kargs, LDS_BYTES, stream);
        if (e != hipSuccess) { fprintf(stderr, "kernel_launch: cooperative launch (phase %d) failed: %s (grid %d)\n", p, hipGetErrorString(e), grid); break; } }
#else
    a.ph_lo = 0; a.ph_hi = NPHASES; void* kargs[] = {&a};
    hipError_t e = hipLaunchCooperativeKernel((void*)fwd_megakernel, dim3(grid), dim3(NWAVES * 64), kargs, LDS_BYTES, stream);
    if (e != hipSuccess) fprintf(stderr, "kernel_launch: cooperative launch failed: %s (grid %d)\n", hipGetErrorString(e), grid);
#endif
}
```

```cpp
#include <hip/hip_runtime.h>
#include <hip/hip_bf16.h>
#include <hip/hip_cooperative_groups.h>
#include <cstdio>
#include <cstdint>
namespace cg = cooperative_groups;
namespace pg8 {
#define PG8_LAS __attribute__((address_space(3)))
typedef unsigned short bf16_t;
typedef short bf16x8 __attribute__((ext_vector_type(8)));
typedef float f32x4 __attribute__((ext_vector_type(4)));
typedef unsigned u32x4 __attribute__((ext_vector_type(4)));
constexpr int BM = 256, BK = 64, HALF = 128, HTB = HALF * BK * 2  , STAGE_BYTES = 8 * HTB, NXCD = 8, WGM = 8;

__host__ __device__ __forceinline__ int lds_byte(int r, int c) { const int st = (r >> 4) * 2 + (c >> 5), rr = r & 15, cc = c & 31, ob = rr * 64 + cc * 2; return st * 1024 + (ob ^ (((ob >> 9) & 1) << 5)); }
__host__ __device__ __forceinline__ void stage_rc(int b, int& R, int& C) { const int st = b / 1024, sb = b % 1024, swz = sb ^ (((sb >> 9) & 1) << 5); R = (st >> 1) * 16 + swz / 64; C = (st & 1) * 32 + (swz % 64) / 2; }
__host__ __device__ __forceinline__ int perm32(int rho) { const int n = rho >> 4, i = rho & 15; return 8 * (i >> 2) + 4 * n + (i & 3); }

struct Unit { int pm, pn; };
struct Gemm { const bf16_t* A; const bf16_t* Bt; int M, N, K; };

struct StaticOrder {
    int nM, nN, nwg, G, c;
    __host__ __device__ void init(int M, int N, int G_, int c_) { nM = M / BM; nN = N / BM; nwg = nM * nN; G = G_; c = c_; }
    __host__ __device__ bool next(int i, Unit& u) const {
        const long L = (long)i * G + c; if (L >= nwg) return false;
        int wgid = (int)L; { const int q = nwg / NXCD, r = nwg % NXCD, xcd = wgid % NXCD, off = wgid / NXCD; wgid = (xcd < r ? xcd * (q + 1) : r * (q + 1) + (xcd - r) * q) + off; }
        const int nig = WGM * nN, gid = wgid / nig, fm = gid * WGM, gsz = (nM - fm) < WGM ? (nM - fm) : WGM;
        u.pm = fm + ((wgid % nig) % gsz); u.pn = (wgid % nig) / gsz; return true;
    }
    __device__ __forceinline__ void a_ready(const Unit&) const {}
    __device__ __forceinline__ void done(const Unit&) const {}
};
__device__ __forceinline__ unsigned cvt_pk_bf16(float lo, float hi) { unsigned r; asm volatile("v_cvt_pk_bf16_f32 %0, %1, %2" : "=v"(r) : "v"(lo), "v"(hi)); return r; }
#ifndef EPI_WT
#define EPI_WT 0
#endif
__device__ __forceinline__ void st16(void* p, u32x4 v) {
#if EPI_WT == 1
    asm volatile("global_store_dwordx4 %0, %1, off sc1\n\ts_nop 1" :: "v"(p), "v"(v) : "memory");
#elif EPI_WT == 2
    __builtin_nontemporal_store(v, (u32x4*)p);
#else
    *(u32x4*)p = v;
#endif
}
__device__ __forceinline__ void st16f(void* p, f32x4 v) {
#if EPI_WT == 1
    asm volatile("global_store_dwordx4 %0, %1, off sc1\n\ts_nop 1" :: "v"(p), "v"(v) : "memory");
#elif EPI_WT == 2
    __builtin_nontemporal_store(v, (f32x4*)p);
#else
    *(f32x4*)p = v;
#endif
}
__device__ __forceinline__ void st8(void* p, unsigned long long v) {
#if EPI_WT == 1
    asm volatile("global_store_dwordx2 %0, %1, off sc1\n\ts_nop 1" :: "v"(p), "v"(v) : "memory");
#elif EPI_WT == 2
    __builtin_nontemporal_store(v, (unsigned long long*)p);
#else
    *(unsigned long long*)p = v;
#endif
}
struct EpiBf16S {
    static constexpr bool PERM = true, AFTER_DRAIN = false;
    bf16_t* O; int ldc; int s_lo, s_hi; float scale; const float* rowss;
    __device__ __forceinline__ void operator()(const f32x4 (&acc)[2][2][4][2], const Unit& u, int wr, int wc, int fr, int fq) const {
        const int row0 = u.pm * BM + wr * 64 + fr, col0 = u.pn * BM + wc * 32 + 8 * fq;
        const float sc = (u.pn >= s_lo && u.pn < s_hi) ? scale : 1.f;
        float rss[2][4];
#pragma unroll
        for (int ai = 0; ai < 2; ++ai)
#pragma unroll
            for (int m = 0; m < 4; ++m) rss[ai][m] = rowss ? rowss[row0 + ai * HALF + m * 16] : 0.f;
#pragma unroll
        for (int ai = 0; ai < 2; ++ai)
#pragma unroll
            for (int m = 0; m < 4; ++m) { bf16_t* rowp = O + (size_t)(row0 + ai * HALF + m * 16) * ldc + col0;
                const float rsc = rowss ? sc * rsqrtf(rss[ai][m] * (1.f / 2048.f) + 1e-6f) : sc;
#pragma unroll
                for (int bj = 0; bj < 2; ++bj) { const f32x4 v0 = acc[ai][bj][m][0] * rsc, v1 = acc[ai][bj][m][1] * rsc;
                    u32x4 w; w.x = cvt_pk_bf16(v0[0], v0[1]); w.y = cvt_pk_bf16(v0[2], v0[3]); w.z = cvt_pk_bf16(v1[0], v1[1]); w.w = cvt_pk_bf16(v1[2], v1[3]);
                    st16(rowp + bj * HALF, w); } }
    }
};
struct EpiResF32 {
    static constexpr bool PERM = false, AFTER_DRAIN = false;
    const float* res; float* out; int ld;
    __device__ __forceinline__ void operator()(const f32x4 (&acc)[2][2][4][2], const Unit& u, int wr, int wc, int fr, int fq) const {
        const int row0 = u.pm * BM + wr * 64 + fr, col0 = u.pn * BM + wc * 32 + 4 * fq;
#pragma unroll
        for (int ai = 0; ai < 2; ++ai)
#pragma unroll
            for (int m = 0; m < 4; ++m) { const size_t off = (size_t)(row0 + ai * HALF + m * 16) * ld + col0;
#pragma unroll
                for (int bj = 0; bj < 2; ++bj)
#pragma unroll
                    for (int n = 0; n < 2; ++n) { const size_t idx = off + bj * HALF + n * 16; const f32x4 r = *(const f32x4*)(res + idx); st16f(out + idx, r + acc[ai][bj][m][n]); } }
    }
};
struct EpiResNorm {
    static constexpr bool PERM = false, AFTER_DRAIN = false;
    const float* res; float* out; int ld; const float* gain; bf16_t* xn; float* rowss;
    __device__ __forceinline__ void operator()(const f32x4 (&acc)[2][2][4][2], const Unit& u, int wr, int wc, int fr, int fq) const {
        const int row0 = u.pm * BM + wr * 64 + fr, col0 = u.pn * BM + wc * 32 + 4 * fq;
        f32x4 gv[2][2];
#pragma unroll
        for (int bj = 0; bj < 2; ++bj)
#pragma unroll
            for (int n = 0; n < 2; ++n) gv[bj][n] = *(const f32x4*)(gain + col0 + bj * HALF + n * 16);
#pragma unroll
        for (int ai = 0; ai < 2; ++ai) {
            f32x4 rv[4][2][2];
#pragma unroll
            for (int m = 0; m < 4; ++m)
#pragma unroll
                for (int bj = 0; bj < 2; ++bj)
#pragma unroll
                    for (int n = 0; n < 2; ++n) rv[m][bj][n] = *(const f32x4*)(res + (size_t)(row0 + ai * HALF + m * 16) * ld + col0 + bj * HALF + n * 16);
#pragma unroll
            for (int m = 0; m < 4; ++m) { const int row = row0 + ai * HALF + m * 16; const size_t off = (size_t)row * ld + col0; float ss = 0.f;
#pragma unroll
                for (int bj = 0; bj < 2; ++bj)
#pragma unroll
                    for (int n = 0; n < 2; ++n) { const size_t idx = off + bj * HALF + n * 16; const f32x4 r = rv[m][bj][n] + acc[ai][bj][m][n]; if (out) st16f(out + idx, r);
                        ss += (r[0] * r[0] + r[1] * r[1]) + (r[2] * r[2] + r[3] * r[3]);
                        const f32x4 y = r * gv[bj][n]; unsigned long long w = (unsigned long long)cvt_pk_bf16(y[0], y[1]) | ((unsigned long long)cvt_pk_bf16(y[2], y[3]) << 32);
                        st8(xn + idx, w); }
                ss += __shfl_xor(ss, 16); ss += __shfl_xor(ss, 32);
                if (fq == 0) (void)__hip_atomic_fetch_add(rowss + row, ss, __ATOMIC_RELAXED, __HIP_MEMORY_SCOPE_AGENT); } }
    }
};
struct EpiResNormB {
    static constexpr bool PERM = false, AFTER_DRAIN = false;
    bf16_t* xn; int ld; const float* g0; const float* g1; const float* r0inv; float* rowss;
    __device__ __forceinline__ void operator()(const f32x4 (&acc)[2][2][4][2], const Unit& u, int wr, int wc, int fr, int fq) const {
        const int row0 = u.pm * BM + wr * 64 + fr, col0 = u.pn * BM + wc * 32 + 4 * fq;
        f32x4 rg[2][2], gv[2][2];
#pragma unroll
        for (int bj = 0; bj < 2; ++bj)
#pragma unroll
            for (int n = 0; n < 2; ++n) { const f32x4 g = *(const f32x4*)(g0 + col0 + bj * HALF + n * 16); rg[bj][n] = (f32x4){1.f / g[0], 1.f / g[1], 1.f / g[2], 1.f / g[3]};
                gv[bj][n] = *(const f32x4*)(g1 + col0 + bj * HALF + n * 16); }
        float ri[2][4];
#pragma unroll
        for (int ai = 0; ai < 2; ++ai)
#pragma unroll
            for (int m = 0; m < 4; ++m) ri[ai][m] = r0inv[row0 + ai * HALF + m * 16];
#pragma unroll
        for (int ai = 0; ai < 2; ++ai) {
            unsigned long long xv[4][2][2];
#pragma unroll
            for (int m = 0; m < 4; ++m)
#pragma unroll
                for (int bj = 0; bj < 2; ++bj)
#pragma unroll
                    for (int n = 0; n < 2; ++n) xv[m][bj][n] = *(const unsigned long long*)(xn + (size_t)(row0 + ai * HALF + m * 16) * ld + col0 + bj * HALF + n * 16);
#pragma unroll
            for (int m = 0; m < 4; ++m) { const int row = row0 + ai * HALF + m * 16; const size_t off = (size_t)row * ld + col0; float ss = 0.f;
#pragma unroll
                for (int bj = 0; bj < 2; ++bj)
#pragma unroll
                    for (int n = 0; n < 2; ++n) { const size_t idx = off + bj * HALF + n * 16; const unsigned long long w = xv[m][bj][n];
                        const unsigned lo = (unsigned)w, hi = (unsigned)(w >> 32);
                        const f32x4 r = (f32x4){__uint_as_float(lo << 16), __uint_as_float(lo & 0xffff0000u), __uint_as_float(hi << 16), __uint_as_float(hi & 0xffff0000u)} * rg[bj][n] * ri[ai][m] + acc[ai][bj][m][n];
                        ss += (r[0] * r[0] + r[1] * r[1]) + (r[2] * r[2] + r[3] * r[3]);
                        const f32x4 y = r * gv[bj][n];
                        st8(xn + idx, (unsigned long long)cvt_pk_bf16(y[0], y[1]) | ((unsigned long long)cvt_pk_bf16(y[2], y[3]) << 32)); }
                ss += __shfl_xor(ss, 16); ss += __shfl_xor(ss, 32);
                if (fq == 0) (void)__hip_atomic_fetch_add(rowss + row, ss, __ATOMIC_RELAXED, __HIP_MEMORY_SCOPE_AGENT); } }
    }
};
struct EpiResBf16G {
    static constexpr bool PERM = false, AFTER_DRAIN = false;
    bf16_t* xn; int ld; const float* gain; float* rowss;
    __device__ __forceinline__ void operator()(const f32x4 (&acc)[2][2][4][2], const Unit& u, int wr, int wc, int fr, int fq) const {
        const int row0 = u.pm * BM + wr * 64 + fr, col0 = u.pn * BM + wc * 32 + 4 * fq;
        f32x4 rg[2][2];
#pragma unroll
        for (int bj = 0; bj < 2; ++bj)
#pragma unroll
            for (int n = 0; n < 2; ++n) { const f32x4 g = *(const f32x4*)(gain + col0 + bj * HALF + n * 16); rg[bj][n] = (f32x4){1.f / g[0], 1.f / g[1], 1.f / g[2], 1.f / g[3]}; }
#pragma unroll
        for (int ai = 0; ai < 2; ++ai) {
            unsigned long long xv[4][2][2];
#pragma unroll
            for (int m = 0; m < 4; ++m)
#pragma unroll
                for (int bj = 0; bj < 2; ++bj)
#pragma unroll
                    for (int n = 0; n < 2; ++n) xv[m][bj][n] = *(const unsigned long long*)(xn + (size_t)(row0 + ai * HALF + m * 16) * ld + col0 + bj * HALF + n * 16);
#pragma unroll
            for (int m = 0; m < 4; ++m) { const int row = row0 + ai * HALF + m * 16; const size_t off = (size_t)row * ld + col0; float ss = 0.f;
#pragma unroll
                for (int bj = 0; bj < 2; ++bj)
#pragma unroll
                    for (int n = 0; n < 2; ++n) { const size_t idx = off + bj * HALF + n * 16; const unsigned long long w = xv[m][bj][n];
                        const unsigned lo = (unsigned)w, hi = (unsigned)(w >> 32);
                        const f32x4 r = (f32x4){__uint_as_float(lo << 16), __uint_as_float(lo & 0xffff0000u), __uint_as_float(hi << 16), __uint_as_float(hi & 0xffff0000u)} * rg[bj][n] + acc[ai][bj][m][n];
                        ss += (r[0] * r[0] + r[1] * r[1]) + (r[2] * r[2] + r[3] * r[3]);
                        st8(xn + idx, (unsigned long long)cvt_pk_bf16(r[0], r[1]) | ((unsigned long long)cvt_pk_bf16(r[2], r[3]) << 32)); }
                ss += __shfl_xor(ss, 16); ss += __shfl_xor(ss, 32);
                if (fq == 0) (void)__hip_atomic_fetch_add(rowss + row, ss, __ATOMIC_RELAXED, __HIP_MEMORY_SCOPE_AGENT); } }
    }
};
template <class Epi, class Sched, bool ALIGN_EPI = false, bool SP2 = false>
__device__ __forceinline__ void gemm_phase(PG8_LAS unsigned char* lds, const Gemm g, const Sched& S, const Epi& E) {
    const int tid = threadIdx.x, wid = __builtin_amdgcn_readfirstlane(tid >> 6), lane = tid & 63, wr = wid >> 2, wc = wid & 3, fr = lane & 15, fq = lane >> 4;
    const int K = g.K, nt = K / BK;
    unsigned voffA[2], voffB[2];
#pragma unroll
    for (int i = 0; i < 2; ++i) { int R, C; stage_rc(tid * 16 + i * 8192, R, C); const int Rb = Epi::PERM ? ((R & ~31) + perm32(R & 31)) : R;
        voffA[i] = (unsigned)(R * K + C) * 2u; voffB[i] = (unsigned)(Rb * K + C) * 2u; }
    const size_t kstep = (size_t)(BK * 2);
    const size_t hstep = (size_t)HALF * K * 2;
    const size_t tstep = 2 * hstep;
    const unsigned ldsw = (unsigned)wid * 1024u;
    const int aoff = lds_byte(wr * 64 + fr, fq * 8), boff = lds_byte(wc * 32 + fr, fq * 8);
#define PG8_SA(b, h) (((b) * 2 + (h)) * HTB)
#define PG8_SB(b, h) ((4 + (b) * 2 + (h)) * HTB)
#define PG8_STAGE(bufoff, gbase, voff) do { _Pragma("unroll") for (int _i = 0; _i < 2; ++_i) \
        __builtin_amdgcn_global_load_lds((const unsigned*)((const char*)(gbase) + (voff)[_i]), (PG8_LAS unsigned*)(lds + (bufoff) + ldsw + _i * 8192), 16, 0, 0); } while (0)
#define PG8_LDA(dst, b, h) do { _Pragma("unroll") for (int m = 0; m < 4; ++m) _Pragma("unroll") for (int k = 0; k < 2; ++k) dst[m][k] = *(const PG8_LAS bf16x8*)(lds + PG8_SA(b, h) + aoff + m * 2048 + k * 1024); } while (0)
#define PG8_LDB(dst, b, h) do { _Pragma("unroll") for (int n = 0; n < 2; ++n) _Pragma("unroll") for (int k = 0; k < 2; ++k) dst[n][k] = *(const PG8_LAS bf16x8*)(lds + PG8_SB(b, h) + boff + n * 2048 + k * 1024); } while (0)
#define PG8_MMA(ai, bj, At, Bt) do { __builtin_amdgcn_s_setprio(1); _Pragma("unroll") for (int m = 0; m < 4; ++m) _Pragma("unroll") for (int n = 0; n < 2; ++n) _Pragma("unroll") for (int k = 0; k < 2; ++k) \
        acc[ai][bj][m][n] = __builtin_amdgcn_mfma_f32_16x16x32_bf16(Bt[n][k], At[m][k], acc[ai][bj][m][n], 0, 0, 0); __builtin_amdgcn_s_setprio(0); } while (0)
#define PG8_WAIT_V(n) asm volatile("s_waitcnt vmcnt(" #n ")" ::: "memory")
#define PG8_WAIT_L(n) asm volatile("s_waitcnt lgkmcnt(" #n ")" ::: "memory")
#define PG8_BAR __builtin_amdgcn_s_barrier()
#define PG8_SCHED __builtin_amdgcn_sched_barrier(0)
    Unit cur, nxt; int ui = 0;
    if (!S.next(0, cur)) return;
    f32x4 acc[2][2][4][2];
#pragma unroll
    for (int a = 0; a < 2; ++a)
#pragma unroll
        for (int b = 0; b < 2; ++b)
#pragma unroll
            for (int m = 0; m < 4; ++m)
#pragma unroll
                for (int n = 0; n < 2; ++n) acc[a][b][m][n] = (f32x4){0.f, 0.f, 0.f, 0.f};
    bf16x8 At[4][2], B0[2][2], B1[2][2];
    const char* cA = (const char*)g.A + (size_t)cur.pm * tstep; const char* cB = (const char*)g.Bt + (size_t)cur.pn * tstep;
    S.a_ready(cur);
    if constexpr (SP2) {
        PG8_STAGE(PG8_SB(0, 0), cB, voffB); PG8_STAGE(PG8_SB(0, 1), cB + hstep, voffB); PG8_STAGE(PG8_SA(0, 0), cA, voffA); PG8_STAGE(PG8_SA(0, 1), cA + hstep, voffA);
        if (wr == 1) PG8_BAR;
        PG8_WAIT_V(2); PG8_BAR;
        PG8_STAGE(PG8_SB(1, 0), cB + kstep, voffB); PG8_STAGE(PG8_SA(1, 0), cA + kstep, voffA); PG8_STAGE(PG8_SB(1, 1), cB + hstep + kstep, voffB);
        PG8_WAIT_V(6); PG8_BAR;
    } else {
        PG8_STAGE(PG8_SB(0, 0), cB, voffB); PG8_STAGE(PG8_SA(0, 0), cA, voffA); PG8_STAGE(PG8_SB(0, 1), cB + hstep, voffB); PG8_STAGE(PG8_SA(0, 1), cA + hstep, voffA);
        if (wr == 1) PG8_BAR;
        PG8_WAIT_V(4); PG8_BAR;
        PG8_STAGE(PG8_SB(1, 0), cB + kstep, voffB); PG8_STAGE(PG8_SA(1, 0), cA + kstep, voffA); PG8_STAGE(PG8_SB(1, 1), cB + hstep + kstep, voffB);
        PG8_WAIT_V(6); PG8_BAR;
    }
    for (;;) {
        const bool has_next = S.next(ui + 1, nxt);
        const char* nA = has_next ? (const char*)g.A + (size_t)nxt.pm * tstep : cA; const char* nB = has_next ? (const char*)g.Bt + (size_t)nxt.pn * tstep : cB;
        for (int t = 0; t < nt; t += 2) {
            const bool last = (t == nt - 2);
            const char* a1 = cA + (size_t)(t + 1) * kstep;
            const char* a2 = last ? nA : cA + (size_t)(t + 2) * kstep; const char* b2 = last ? nB : cB + (size_t)(t + 2) * kstep;
            const char* a3 = a2 + kstep; const char* b3 = b2 + kstep;
            if (last && has_next) S.a_ready(nxt);
            if constexpr (SP2) {
            PG8_LDB(B0, 0, 0); PG8_LDB(B1, 0, 1); PG8_SCHED; PG8_LDA(At, 0, 0); PG8_STAGE(PG8_SA(1, 1), a1 + hstep, voffA);
            PG8_WAIT_V(8); PG8_WAIT_L(0); PG8_BAR; PG8_MMA(0, 0, At, B0); PG8_MMA(0, 1, At, B1); PG8_BAR; PG8_SCHED;
            PG8_LDA(At, 0, 1); PG8_STAGE(PG8_SB(0, 0), b2, voffB); PG8_STAGE(PG8_SB(0, 1), b2 + hstep, voffB); PG8_STAGE(PG8_SA(0, 0), a2, voffA);
            PG8_WAIT_V(8); PG8_WAIT_L(0); PG8_BAR; PG8_MMA(1, 0, At, B0); PG8_MMA(1, 1, At, B1); PG8_BAR; PG8_SCHED;
            PG8_LDB(B0, 1, 0); PG8_LDB(B1, 1, 1); PG8_SCHED; PG8_LDA(At, 1, 0); PG8_STAGE(PG8_SA(0, 1), a2 + hstep, voffA);
            PG8_WAIT_V(8); PG8_WAIT_L(0); PG8_BAR; PG8_MMA(0, 0, At, B0); PG8_MMA(0, 1, At, B1); PG8_BAR; PG8_SCHED;
            PG8_LDA(At, 1, 1); PG8_STAGE(PG8_SB(1, 0), b3, voffB); PG8_STAGE(PG8_SB(1, 1), b3 + hstep, voffB); PG8_STAGE(PG8_SA(1, 0), a3, voffA);
            PG8_WAIT_V(8); PG8_WAIT_L(0); PG8_BAR; PG8_MMA(1, 0, At, B0); PG8_MMA(1, 1, At, B1); PG8_BAR; PG8_SCHED;
            } else {
            PG8_LDB(B0, 0, 0); PG8_SCHED; PG8_LDA(At, 0, 0); PG8_STAGE(PG8_SA(1, 1), a1 + hstep, voffA);
            PG8_WAIT_L(8); PG8_BAR; PG8_WAIT_L(0); PG8_MMA(0, 0, At, B0); PG8_BAR; PG8_SCHED;
            PG8_LDB(B1, 0, 1); PG8_STAGE(PG8_SB(0, 0), b2, voffB);
            PG8_BAR; PG8_WAIT_L(0); PG8_MMA(0, 1, At, B1); PG8_BAR;
            PG8_LDA(At, 0, 1); PG8_STAGE(PG8_SA(0, 0), a2, voffA);
            PG8_BAR; PG8_WAIT_L(0); PG8_MMA(1, 0, At, B0); PG8_BAR; PG8_SCHED;
            PG8_STAGE(PG8_SB(0, 1), b2 + hstep, voffB);
            PG8_WAIT_V(6); PG8_BAR; PG8_MMA(1, 1, At, B1); PG8_BAR;
            PG8_LDB(B0, 1, 0); PG8_SCHED; PG8_LDA(At, 1, 0); PG8_STAGE(PG8_SA(0, 1), a2 + hstep, voffA);
            PG8_WAIT_L(8); PG8_BAR; PG8_WAIT_L(0); PG8_MMA(0, 0, At, B0); PG8_BAR; PG8_SCHED;
            PG8_LDB(B1, 1, 1); PG8_STAGE(PG8_SB(1, 0), b3, voffB);
            PG8_BAR; PG8_WAIT_L(0); PG8_MMA(0, 1, At, B1); PG8_BAR;
            PG8_LDA(At, 1, 1); PG8_STAGE(PG8_SA(1, 0), a3, voffA);
            PG8_BAR; PG8_WAIT_L(0); PG8_MMA(1, 0, At, B0); PG8_BAR; PG8_SCHED;
            PG8_STAGE(PG8_SB(1, 1), b3 + hstep, voffB);
            PG8_WAIT_V(6); PG8_BAR; PG8_MMA(1, 1, At, B1); PG8_BAR;
            }
        }
        if constexpr (ALIGN_EPI) { if (wr == 0) PG8_BAR; }
        if constexpr (!Epi::AFTER_DRAIN) { E(acc, cur, wr, wc, fr, fq); S.done(cur); }
        if (!has_next) break;
#pragma unroll
        for (int a = 0; a < 2; ++a)
#pragma unroll
            for (int b = 0; b < 2; ++b)
#pragma unroll
                for (int m = 0; m < 4; ++m)
#pragma unroll
                    for (int n = 0; n < 2; ++n) acc[a][b][m][n] = (f32x4){0.f, 0.f, 0.f, 0.f};
        cur = nxt; cA = nA; cB = nB; ++ui;
        if constexpr (ALIGN_EPI) { if (wr == 1) PG8_BAR; }
    }
    PG8_WAIT_V(0);
    if constexpr (!ALIGN_EPI) { if (wr == 0) PG8_BAR; }
    PG8_BAR;
    if constexpr (Epi::AFTER_DRAIN) { E.fused(acc, cur, wr, wc, fr, fq, lds, wid, lane); S.done(cur); }
#undef PG8_SA
#undef PG8_SB
#undef PG8_STAGE
#undef PG8_LDA
#undef PG8_LDB
#undef PG8_MMA
#undef PG8_WAIT_V
#undef PG8_WAIT_L
#undef PG8_BAR
#undef PG8_SCHED
}
}
namespace att {
using bf16 = __hip_bfloat16;
constexpr int   D = 128, NW = 8, QBLK = 32, KVBLK = 64;
constexpr float SCALE = 0.088388347648318440f;
constexpr float THR = 8.f;
constexpr int SDEPTH = 2;
constexpr int LDQ = 4608, LDK = 4608, LDO = 2048, LDG = 4608;
constexpr size_t SHM_V = KVBLK * D * 2, SHM_K = KVBLK * D * 2, SHM_ATTN = 2 * SHM_V + 2 * SHM_K + NW * 64 * 4;
constexpr int OST_OFF = 67584;
using bf16x8 = __attribute__((ext_vector_type(8))) short;
using s16x4  = __attribute__((ext_vector_type(4))) short;
using f32x16 = __attribute__((ext_vector_type(16))) float;
using f32x8  = __attribute__((ext_vector_type(8))) float;
using u32x4  = __attribute__((ext_vector_type(4))) unsigned;
#define KSWZ(row, colB) ((row) * 256 + ((colB) ^ (((row) & 7) << 4)))
#define SBAR() __builtin_amdgcn_sched_barrier(0)
__device__ __forceinline__ int crow(int r, int hi) { return (r & 3) + 8 * (r >> 2) + 4 * hi; }
__device__ __forceinline__ unsigned cvtpk(float lo, float hi) {
  unsigned r; asm volatile("v_cvt_pk_bf16_f32 %0, %1, %2" : "=v"(r) : "v"(lo), "v"(hi)); return r;
}
template <typename TIn> struct Stage;
template <> struct Stage<bf16>  { using T = bf16x8;
  __device__ static __forceinline__ T ld8(const bf16* p) { return *reinterpret_cast<const bf16x8*>(p); }
  __device__ static __forceinline__ bf16x8 tobf(T x) { return x; } };
template <> struct Stage<float> { using T = f32x8;
  __device__ static __forceinline__ T ld8(const float* p) { return *reinterpret_cast<const f32x8*>(p); }
  __device__ static __forceinline__ bf16x8 tobf(T x) {
    u32x4 w = {cvtpk(x[0], x[1]), cvtpk(x[2], x[3]), cvtpk(x[4], x[5]), cvtpk(x[6], x[7])}; return *reinterpret_cast<bf16x8*>(&w); } };

__device__ __forceinline__ void partialSM(f32x16& p0, f32x16& p1, float& m_reg, float& mn, float& alpha) {
  constexpr float C = SCALE * 1.4426950408889634f;
  float pmax = p0[0]; for (int r = 1; r < 16; ++r) pmax = fmaxf(pmax, p0[r]); for (int r = 0; r < 16; ++r) pmax = fmaxf(pmax, p1[r]);
  { auto rr = __builtin_amdgcn_permlane32_swap(__float_as_uint(pmax), __float_as_uint(pmax), false, false);
    pmax = fmaxf(__uint_as_float(rr[0]), __uint_as_float(rr[1])); }
  if (__builtin_expect(__all(pmax - m_reg <= THR / SCALE), 1)) { mn = m_reg; alpha = 1.f; }
  else { mn = fmaxf(m_reg, pmax); alpha = __builtin_amdgcn_exp2f((m_reg - mn) * C); m_reg = mn; }
  float mnC = -mn * C;
  for (int r = 0; r < 16; ++r) p0[r] = fmaf(p0[r], C, mnC); for (int r = 0; r < 16; ++r) p1[r] = fmaf(p1[r], C, mnC);
  for (int r = 0; r < 16; ++r) p0[r] = __builtin_amdgcn_exp2f(p0[r]);
}
__device__ __forceinline__ void finishSM(f32x16& p0, f32x16& p1, float alpha, float& l_reg, bf16x8& pa0, bf16x8& pa1, bf16x8& pa2, bf16x8& pa3) {
  for (int r = 0; r < 16; ++r) p1[r] = __builtin_amdgcn_exp2f(p1[r]);
  float ps = 0; for (int r = 0; r < 16; ++r) ps += p0[r]; for (int r = 0; r < 16; ++r) ps += p1[r];
  { auto rr = __builtin_amdgcn_permlane32_swap(__float_as_uint(ps), __float_as_uint(ps), false, false);
    ps = __uint_as_float(rr[0]) + __uint_as_float(rr[1]); }
  l_reg = l_reg * alpha + ps;
#define PK4(P, BASE, OUT) do { unsigned a0 = cvtpk(P[BASE + 0], P[BASE + 1]), a1 = cvtpk(P[BASE + 2], P[BASE + 3]);   \
    unsigned b0 = cvtpk(P[BASE + 4], P[BASE + 5]), b1 = cvtpk(P[BASE + 6], P[BASE + 7]);                              \
    auto r0 = __builtin_amdgcn_permlane32_swap(a0, b0, false, false); auto r1 = __builtin_amdgcn_permlane32_swap(a1, b1, false, false); \
    u32x4 w = {r0[0], r1[0], r0[1], r1[1]}; OUT = *reinterpret_cast<bf16x8*>(&w); } while (0)
  PK4(p0, 0, pa0); PK4(p0, 8, pa1); PK4(p1, 0, pa2); PK4(p1, 8, pa3);
#undef PK4
}
__device__ __forceinline__ void qkt(f32x16& p0, f32x16& p1, const bf16* Ks, const bf16x8* qr, int r32, int hi) {
  p0 = f32x16{}; p1 = f32x16{};
  for (int d0 = 0; d0 < 8; ++d0) { int cb = (d0 * 16 + hi * 8) * 2;
    bf16x8 b0 = *reinterpret_cast<const bf16x8*>((const char*)Ks + KSWZ(r32, cb));
    bf16x8 b1 = *reinterpret_cast<const bf16x8*>((const char*)Ks + KSWZ(32 + r32, cb));
    p0 = __builtin_amdgcn_mfma_f32_32x32x16_bf16(b0, qr[d0], p0, 0, 0, 0);
    p1 = __builtin_amdgcn_mfma_f32_32x32x16_bf16(b1, qr[d0], p1, 0, 0, 0); }
}
__device__ __forceinline__ int v_st(int k, int c) { const int kk = (k & ~0xC) | ((k & 4) << 1) | ((k & 8) >> 1); return ((kk >> 3) * 4 + (c >> 5)) * 512 + ((kk & 7) * 32 + (c & 31)) * 2; }
__device__ __forceinline__ int v_rd_base(int lane) { return ((lane & 3) << 3) | (((lane >> 2) & 3) << 6) | (((lane >> 4) & 1) << 5) | (((lane >> 5) & 1) << 8); }
constexpr int v_rd_off(int d0, int ks, int half) { return d0 * 512 + ks * 4096 + half * 2048; }
template <int OFF> __device__ __forceinline__ s16x4 tr_read(int vb) {
  s16x4 r; asm volatile("ds_read_b64_tr_b16 %0, %1 offset:%2" : "=&v"(r) : "v"(vb), "i"(OFF) : "memory"); return r;
}
template <int D0> __device__ __forceinline__ void pv_one(f32x16& od, int vb, bf16x8 pa0, bf16x8 pa1, bf16x8 pa2, bf16x8 pa3) {
  const s16x4 l0 = tr_read<v_rd_off(D0, 0, 0)>(vb), h0 = tr_read<v_rd_off(D0, 0, 1)>(vb), l1 = tr_read<v_rd_off(D0, 1, 0)>(vb), h1 = tr_read<v_rd_off(D0, 1, 1)>(vb);
  const s16x4 l2 = tr_read<v_rd_off(D0, 2, 0)>(vb), h2 = tr_read<v_rd_off(D0, 2, 1)>(vb), l3 = tr_read<v_rd_off(D0, 3, 0)>(vb), h3 = tr_read<v_rd_off(D0, 3, 1)>(vb);
  asm volatile("s_waitcnt lgkmcnt(0)" ::: "memory"); SBAR();
#define PK(L, H) (bf16x8){L[0], L[1], L[2], L[3], H[0], H[1], H[2], H[3]}
  od = __builtin_amdgcn_mfma_f32_32x32x16_bf16(pa0, PK(l0, h0), od, 0, 0, 0);
  od = __builtin_amdgcn_mfma_f32_32x32x16_bf16(pa1, PK(l1, h1), od, 0, 0, 0);
  od = __builtin_amdgcn_mfma_f32_32x32x16_bf16(pa2, PK(l2, h2), od, 0, 0, 0);
  od = __builtin_amdgcn_mfma_f32_32x32x16_bf16(pa3, PK(l3, h3), od, 0, 0, 0);
#undef PK
}
__device__ __forceinline__ void pv_d0(f32x16* o, int vb, bf16x8 pa0, bf16x8 pa1, bf16x8 pa2, bf16x8 pa3) {
  pv_one<0>(o[0], vb, pa0, pa1, pa2, pa3); pv_one<1>(o[1], vb, pa0, pa1, pa2, pa3); pv_one<2>(o[2], vb, pa0, pa1, pa2, pa3); pv_one<3>(o[3], vb, pa0, pa1, pa2, pa3);
}

template <typename TQ>
__device__ __forceinline__ void attn_dense_body(const TQ* __restrict__ Qb, const bf16* __restrict__ Kh, const bf16* __restrict__ Vh,
                                                unsigned short* __restrict__ Ob, const unsigned short* __restrict__ Gb, int seq, char* lds) {
  using St = Stage<bf16>; using SQ = Stage<TQ>;
  const int tid = threadIdx.x, wid = tid >> 6, lane = tid & 63, r32 = lane & 31, hi = lane >> 5;
  bf16* V_lds = (bf16*)lds; bf16* K_lds = (bf16*)(lds + 2 * SHM_V);
  float* ws = (float*)(lds + 2 * SHM_V + 2 * SHM_K) + wid * 64; float* li_l = ws; float* al_l = ws + 32;
  float m_reg = -1e30f, l_reg = 0; f32x16 o[4] = {}; bf16x8 qr[8];
  const TQ* Qw = Qb + (long)(wid * QBLK + r32) * LDQ + hi * 8;
#pragma unroll
  for (int d0 = 0; d0 < 8; ++d0) qr[d0] = SQ::tobf(SQ::ld8(Qw + d0 * 16));
  const int sr = tid >> 4, sc = (tid & 15) * 8, vst0 = v_st(sr, sc), vst1 = v_st(32 + sr, sc);
  const int vb0 = (int)(uintptr_t)V_lds + v_rd_base(lane);
  struct { typename St::T vs0, vs1, ks0, ks1; } sr_[SDEPTH];
#define SLOAD(i, k0) do { sr_[i].vs0 = St::ld8(&Vh[(long)((k0) + sr) * LDK + sc]); sr_[i].vs1 = St::ld8(&Vh[(long)((k0) + 32 + sr) * LDK + sc]); \
    sr_[i].ks0 = St::ld8(&Kh[(long)((k0) + sr) * LDK + sc]); sr_[i].ks1 = St::ld8(&Kh[(long)((k0) + 32 + sr) * LDK + sc]); } while (0)
#define SWRITE(b, i) do { *(bf16x8*)((char*)V_lds + (b) * SHM_V + vst0) = St::tobf(sr_[i].vs0);          \
    *(bf16x8*)((char*)V_lds + (b) * SHM_V + vst1) = St::tobf(sr_[i].vs1); int kc = sc * 2;               \
    *(bf16x8*)((char*)K_lds + (b) * SHM_K + KSWZ(sr, kc)) = St::tobf(sr_[i].ks0);                       \
    *(bf16x8*)((char*)K_lds + (b) * SHM_K + KSWZ(32 + sr, kc)) = St::tobf(sr_[i].ks1); } while (0)
#define SWAIT() do { if constexpr (SDEPTH == 2) asm volatile("s_waitcnt vmcnt(4)" ::: "memory"); else asm volatile("s_waitcnt vmcnt(0)" ::: "memory"); } while (0)
#define RESC(a) do { if (__any((a) < 1.f)) { if (hi == 0) al_l[r32] = (a); asm volatile("s_waitcnt lgkmcnt(0)" ::: "memory"); \
    for (int d = 0; d < 4; ++d) for (int r = 0; r < 16; ++r) o[d][r] *= al_l[crow(r, hi)]; } } while (0)
  f32x16 pA0, pA1, pB0, pB1; float mnA, mnB, alA, alB; bf16x8 pa0, pa1, pa2, pa3; const int NT = seq / KVBLK;
  constexpr int SE = 0, SO = SDEPTH - 1;
  SLOAD(SE, 0); asm volatile("s_waitcnt vmcnt(0)" ::: "memory"); SWRITE(0, SE); __syncthreads();
  qkt(pA0, pA1, K_lds, qr, r32, hi); partialSM(pA0, pA1, m_reg, mnA, alA);
  SLOAD(SO, KVBLK); if constexpr (SDEPTH == 2) { if (2 < NT) SLOAD(SE, 2 * KVBLK); }
  SWAIT(); SWRITE(1, SO); __syncthreads();
  for (int j = 1; j + 1 < NT; j += 2) {
    SBAR(); qkt(pB0, pB1, (bf16*)((char*)K_lds + SHM_K), qr, r32, hi);
    finishSM(pA0, pA1, alA, l_reg, pa0, pa1, pa2, pa3); SBAR();
    SLOAD(SO, (j + SDEPTH) * KVBLK); SBAR();
    pv_d0(o, vb0, pa0, pa1, pa2, pa3); partialSM(pB0, pB1, m_reg, mnB, alB);
    __syncthreads(); SWAIT(); SWRITE(0, SE);
    RESC(alB); __syncthreads();
    SBAR(); qkt(pA0, pA1, K_lds, qr, r32, hi);
    finishSM(pB0, pB1, alB, l_reg, pa0, pa1, pa2, pa3); SBAR();
    if (SDEPTH == 1 || j + 3 < NT) SLOAD(SE, (j + 1 + SDEPTH) * KVBLK); SBAR();
    pv_d0(o, vb0 + (int)SHM_V, pa0, pa1, pa2, pa3); partialSM(pA0, pA1, m_reg, mnA, alA);
    __syncthreads(); SWAIT(); SWRITE(1, SO);
    RESC(alA); __syncthreads();
  }
  SBAR(); qkt(pB0, pB1, (bf16*)((char*)K_lds + SHM_K), qr, r32, hi);
  finishSM(pA0, pA1, alA, l_reg, pa0, pa1, pa2, pa3); SBAR();
  pv_d0(o, vb0, pa0, pa1, pa2, pa3); partialSM(pB0, pB1, m_reg, mnB, alB);
  __syncthreads(); RESC(alB);
  finishSM(pB0, pB1, alB, l_reg, pa0, pa1, pa2, pa3); SBAR();
  pv_d0(o, vb0 + (int)SHM_V, pa0, pa1, pa2, pa3);
  if (hi == 0) li_l[r32] = l_reg; asm volatile("s_waitcnt lgkmcnt(0)" ::: "memory");
  float rli[16];
#pragma unroll
  for (int r = 0; r < 16; ++r) rli[r] = __builtin_amdgcn_rcpf(li_l[crow(r, hi)]);
  int lane_e = lane, wide = wid; asm volatile("" : "+v"(lane_e), "+v"(wide));
  char* ost = lds + OST_OFF + wide * (QBLK * 272);
  { char* osw = ost + (4 * (lane_e >> 5)) * 272 + (lane_e & 31) * 2;
#pragma unroll
  for (int r = 0; r < 16; ++r) { const int orow = (r & 3) + 8 * (r >> 2);
#pragma unroll
    for (int d0 = 0; d0 < 4; ++d0) { unsigned uu = __float_as_uint(o[d0][r] * rli[r]); uu = (uu + 0x7fffu + ((uu >> 16) & 1u)) >> 16;
      *(unsigned short*)(osw + orow * 272 + d0 * 64) = (unsigned short)uu; } } }
  asm volatile("s_waitcnt lgkmcnt(0)" ::: "memory");
  const int rowl = lane_e >> 4, ch = lane_e & 15;
  unsigned short* Ow = Ob + (long)(wide * QBLK + rowl) * LDO + ch * 8; const unsigned short* Gw = Gb + (long)(wide * QBLK + rowl) * LDG + ch * 8;
#pragma unroll
  for (int i = 0; i < 8; ++i) { if ((i & 3) == 0) SBAR();
    const u32x4 ov = *reinterpret_cast<const u32x4*>(ost + (rowl + 4 * i) * 272 + ch * 16);
    const u32x4 gv = *reinterpret_cast<const u32x4*>(Gw + (long)(4 * i) * LDG);
    u32x4 res;
#pragma unroll
    for (int e = 0; e < 4; ++e) { const float g0 = __uint_as_float(gv[e] << 16), g1 = __uint_as_float(gv[e] & 0xffff0000u);
      const float o0 = __uint_as_float(ov[e] << 16), o1 = __uint_as_float(ov[e] & 0xffff0000u);
      res[e] = cvtpk(o0 * g0 * __builtin_amdgcn_rcpf(1.f + __expf(-g0)), o1 * g1 * __builtin_amdgcn_rcpf(1.f + __expf(-g1))); }
    *reinterpret_cast<u32x4*>(Ow + (long)(4 * i) * LDO) = res; }
#undef SLOAD
#undef SWRITE
#undef SWAIT
#undef RESC
}
}
#define LAS __attribute__((address_space(3)))
typedef unsigned short u16;
typedef short bf16x8 __attribute__((ext_vector_type(8)));
typedef float f32x4 __attribute__((ext_vector_type(4)));
typedef unsigned u32x4 __attribute__((ext_vector_type(4)));
typedef unsigned u32x2 __attribute__((ext_vector_type(2)));

constexpr int NWAVES = 8;
#ifndef PG8_SP2
#define PG8_SP2 true
#endif
constexpr int BATCH = 8, SEQ = 2048, DM = 2048, M = BATCH * SEQ;
constexpr int EVEN_IN = 4608, ODD_IN = 8224, ODD_MAIN = 8192;
constexpr float EPS = 1e-6f;
constexpr int C_Q = 0, C_K = 1024, C_V = 1280, C_GA = 1536, C_XL = 2560, C_GL = 3584;
constexpr int D_Q = 0, D_K = 1024, D_V = 2048, D_O = 4096, D_Z = 6144;
constexpr int NPHASES = 11;

constexpr size_t MiB = 1u << 20;
constexpr size_t WS_W0T = 0;
constexpr size_t WS_WO0T = 18 * MiB;
constexpr size_t WS_W1T = 26 * MiB;
constexpr size_t WS_WO1T = 58 * MiB;
constexpr size_t WS_WG1T = 66 * MiB;
constexpr size_t WS_LW = 67 * MiB;
constexpr size_t WS_ROPE = 68 * MiB;
constexpr size_t WS_AGG = 69 * MiB;
constexpr size_t WS_GATES = 71 * MiB;
constexpr size_t WS_SUMSQ = 73 * MiB;
constexpr size_t WS_XN = 74 * MiB;
constexpr size_t WS_MIX = 138 * MiB;
constexpr size_t WS_BIG = 202 * MiB;
constexpr size_t WS_HL = WS_BIG + 144 * MiB, WS_PP = WS_HL + 64 * MiB, WS_END = WS_PP + 64 * MiB;

constexpr size_t WS_CTL = 480 * MiB, CTL_BYTES = 16384, WS_TOTAL = WS_CTL + CTL_BYTES;
constexpr int LDS_BYTES = 147456;
constexpr int LDS_MISC = LDS_BYTES - 64;

struct Args { const float* in[18]; float* out; unsigned char* ws; int ph_lo, ph_hi; };

struct Frame {
    LAS unsigned char* lds; char* lds_g;
    int tid, lane, wave, G, gw, NGW;
    const float *x, *norm_gain, *final_gain, *w_in0, *w_out0, *qg, *kg, *conv_w, *conv_b, *lru_wa, *lru_ba, *lru_wx, *lru_bx, *lru_lam, *w_in1, *gate_bias, *norm1, *w_out1;
    float* out;
    unsigned char* ws;
};

__device__ __forceinline__ float bf2f(unsigned b) { return __uint_as_float(b << 16); }
__device__ __forceinline__ unsigned f2bf(float f) { unsigned u = __float_as_uint(f); return (u + 0x7fffu + ((u >> 16) & 1u)) >> 16; }
__device__ __forceinline__ unsigned pk2(float lo, float hi) { return f2bf(lo) | (f2bf(hi) << 16); }
__device__ __forceinline__ float lo16(unsigned w) { return __uint_as_float(w << 16); }
__device__ __forceinline__ float hi16(unsigned w) { return __uint_as_float(w & 0xffff0000u); }
__device__ __forceinline__ float sigmoidf_(float x) { return __builtin_amdgcn_rcpf(1.f + __expf(-x)); }
__device__ __forceinline__ float siluf_(float x) { return x * __builtin_amdgcn_rcpf(1.f + __expf(-x)); }
__device__ __forceinline__ float logsigf_(float x) { return fminf(x, 0.f) - log1pf(__expf(-fabsf(x))); }
__device__ __forceinline__ float wave_sum(float v) {
#pragma unroll
    for (int o = 1; o < 64; o <<= 1) v += __shfl_xor(v, o);
    return v;
}
#define MFMA16(a, b, c) __builtin_amdgcn_mfma_f32_16x16x32_bf16((a), (b), (c), 0, 0, 0)

__device__ __forceinline__ void transpose_item(const float* W, int ldw, int k0, int n0, u16* WT, int ldt, int trow0, LAS float* scr, int lane) {
#pragma unroll
    for (int i = 0; i < 32; ++i) { const int kk = 2 * i + (lane >> 5); scr[kk * 33 + (lane & 31)] = W[(size_t)(k0 + kk) * ldw + n0 + (lane & 31)]; }
    asm volatile("s_waitcnt lgkmcnt(0)" ::: "memory");
    const int c = lane & 7;
#pragma unroll
    for (int j = 0; j < 4; ++j) { const int n = (lane >> 3) + 8 * j; const LAS float* s = scr + (8 * c) * 33 + n;
        u32x4 o; o.x = pk2(s[0 * 33], s[1 * 33]); o.y = pk2(s[2 * 33], s[3 * 33]); o.z = pk2(s[4 * 33], s[5 * 33]); o.w = pk2(s[6 * 33], s[7 * 33]);
        *(u32x4*)(WT + (size_t)(trow0 + n) * ldt + k0 + 8 * c) = o; }
    asm volatile("s_waitcnt lgkmcnt(0)" ::: "memory");
}
__device__ __forceinline__ void rms_row_to_bf16(const float* xrow, const float* gain, u16* orow, int lane, float* rinv) {
    const f32x4* xr = (const f32x4*)xrow + lane; const f32x4* gr = (const f32x4*)gain + lane;
    f32x4 v[8]; float s = 0.f;
#pragma unroll
    for (int j = 0; j < 8; ++j) { v[j] = xr[64 * j]; s += (v[j].x * v[j].x + v[j].y * v[j].y) + (v[j].z * v[j].z + v[j].w * v[j].w); }
    const float ms = wave_sum(s) * (1.f / DM) + EPS; const float r = rsqrtf(ms);
    if (lane == 0) *rinv = sqrtf(ms);
    unsigned long long* o8 = (unsigned long long*)orow + lane;
#pragma unroll
    for (int j = 0; j < 8; ++j) { const f32x4 g = gr[64 * j];
        o8[64 * j] = (unsigned long long)pk2(v[j].x * r * g.x, v[j].y * r * g.y) | ((unsigned long long)pk2(v[j].z * r * g.z, v[j].w * r * g.w) << 32); }
}
__device__ __forceinline__ void w1_item(Frame& F, int r, LAS float* scr) {
    const int kb = r / 257, nb = r % 257;
    if (nb < 256) transpose_item(F.w_in1, ODD_IN, 64 * kb, 32 * nb, ((u16*)(F.ws + WS_W1T)), DM, 32 * nb, scr, F.lane);
    else          transpose_item(F.w_in1, ODD_IN, 64 * kb, ODD_MAIN, ((u16*)(F.ws + WS_WG1T)), DM, 0, scr, F.lane);
}
__device__ __forceinline__ void wo0_item(Frame& F, int r, LAS float* scr) {
    const int kb = r / 64, nb = r % 64; transpose_item(F.w_out0, DM, 64 * kb, 32 * nb, ((u16*)(F.ws + WS_WO0T)), DM, 32 * nb, scr, F.lane);
}
__device__ __forceinline__ void p1_deferred(Frame& F) {
    LAS float* scr = (LAS float*)(F.lds + F.wave * 16384);
    for (int r = ((int)blockIdx.x - 128) * NWAVES + F.wave; r < 32 * 257; r += 128 * NWAVES) w1_item(F, r, scr);
    for (int r = ((int)blockIdx.x - 128) * NWAVES + F.wave; r < 32 * 64; r += 128 * NWAVES) wo0_item(F, r, scr);
}
__device__ __forceinline__ void p0_prologue(Frame& F) {
    LAS float* scr = (LAS float*)(F.lds + F.wave * 16384);
    constexpr int I0 = 32 * 144, I1 = 32 * 64, I2 = 32 * 257, I3 = 32 * 64, I4 = 256;
    constexpr int NITEMS = I0 + I1 + I2 + I3 + I4;
    for (int it = F.gw; it < NITEMS; it += F.NGW) {
        int r = it;
        if (r < I0) { const int kb = r / 144, nb = r % 144; transpose_item(F.w_in0, EVEN_IN, 64 * kb, 32 * nb, ((u16*)(F.ws + WS_W0T)), DM, 32 * nb, scr, F.lane); continue; } r -= I0;
        if (r < I1) { if (F.G != 256) wo0_item(F, r, scr); continue; } r -= I1;
        if (r < I2) { if (F.G != 256) w1_item(F, r, scr); continue; } r -= I2;
        if (r < I3) { const int kb = r / 64, nb = r % 64; transpose_item(F.w_out1, DM, 64 * kb, 32 * nb, ((u16*)(F.ws + WS_WO1T)), DM, 32 * nb, scr, F.lane); continue; } r -= I3;
        {
            const int blk = r >> 3, sub = r & 7, kb = sub >> 2, nb = sub & 3;
            const int dir = blk >> 4, gate = (blk >> 3) & 1, n = blk & 7;
            const float* src = (gate ? F.lru_wx : F.lru_wa) + (size_t)(dir * 8 + n) * 16384;
            transpose_item(src, 128, 64 * kb, 32 * nb, ((u16*)(F.ws + WS_LW)) + (size_t)((dir * 2 + gate) * 8 + n) * 16384, 128, 32 * nb, scr, F.lane);
        }
    }
    {
        const int g = blockIdx.x * (NWAVES * 64) + F.tid;
        if (g < 64 * 32) { const int pos = g >> 5, i = g & 31;
            const float inv = exp2f(-(float)(2 * i) * (13.287712379549449f / 64.f));
            const float ang = (float)pos * inv;
            ((float*)(F.ws + WS_ROPE))[2 * g] = cosf(ang); ((float*)(F.ws + WS_ROPE))[2 * g + 1] = sinf(ang); }
    }
    for (int i = blockIdx.x * (NWAVES * 64) + F.tid; i < 2 * M; i += F.G * NWAVES * 64) ((float*)(F.ws + WS_SUMSQ))[i] = 0.f;
    for (int m = F.gw; m < M; m += F.NGW) rms_row_to_bf16(F.x + (size_t)m * DM, F.norm_gain, ((u16*)(F.ws + WS_XN)) + (size_t)m * DM, F.lane, ((float*)(F.ws + WS_SUMSQ)) + 3 * M + m);
}

__device__ __forceinline__ void qk_norm_rope(Frame& F) {
    const int half = F.lane >> 5, i = F.lane & 31, colh = i >> 4, j = 2 * (i & 15);
    const int e0 = colh * 64 + j;
    const float* gq = F.qg + e0; const float* gk = F.kg + e0;
    const float q0a = gq[0], q0b = gq[1], q1a = gq[32], q1b = gq[33], k0a = gk[0], k0b = gk[1], k1a = gk[32], k1b = gk[33];
    constexpr int TB = 4;
    for (int tok0 = F.gw; tok0 < M; tok0 += TB * F.NGW) {
        unsigned lo[TB][5], hi[TB][5]; f32x4 cs[TB];
#pragma unroll
        for (int q = 0; q < TB; ++q) { const int tok = tok0 + q * F.NGW; const bool ok = tok < M; const int tk = ok ? tok : tok0;
            const u16* p = ((u16*)(F.ws + WS_BIG)) + (size_t)tk * EVEN_IN + half * 128 + e0;
#pragma unroll
            for (int pp = 0; pp < 5; ++pp) { lo[q][pp] = *(const unsigned*)(p + pp * 256); hi[q][pp] = *(const unsigned*)(p + pp * 256 + 32); }
            const int t = tk & (SEQ - 1), pos = colh ? (t & 63) : (t >> 6);
            cs[q] = *(const f32x4*)(((const float*)(F.ws + WS_ROPE)) + (pos * 32 + j) * 2); }
#pragma unroll
        for (int q = 0; q < TB; ++q) { const int tok = tok0 + q * F.NGW; if (tok < M) {
            u16* p = ((u16*)(F.ws + WS_BIG)) + (size_t)tok * EVEN_IN + half * 128 + e0;
#pragma unroll
            for (int pp = 0; pp < 5; ++pp) {
                float x0a = lo16(lo[q][pp]), x0b = hi16(lo[q][pp]), x1a = lo16(hi[q][pp]), x1b = hi16(hi[q][pp]);
                float ss = (x0a * x0a + x0b * x0b) + (x1a * x1a + x1b * x1b);
#pragma unroll
                for (int o = 1; o < 32; o <<= 1) ss += __shfl_xor(ss, o);
                const float r = rsqrtf(ss * (1.f / 128.f) + EPS);
                x0a *= r * (pp < 4 ? q0a : k0a); x0b *= r * (pp < 4 ? q0b : k0b); x1a *= r * (pp < 4 ? q1a : k1a); x1b *= r * (pp < 4 ? q1b : k1b);
                *(unsigned*)(p + pp * 256) = pg8::cvt_pk_bf16(x0a * cs[q][0] - x1a * cs[q][1], x0b * cs[q][2] - x1b * cs[q][3]);
                *(unsigned*)(p + pp * 256 + 32) = pg8::cvt_pk_bf16(x0a * cs[q][1] + x1a * cs[q][0], x0b * cs[q][3] + x1b * cs[q][2]);
            } } }
    }
}

constexpr int LP = 136;
template <int DIR>
__device__ __forceinline__ void lru_dir(Frame& F, int b, int c, int n, LAS u16* XC, LAS u16* OH, LAS u16* OP) {
    const int wv = F.wave, lane = F.lane, fr = lane & 15, fq = lane >> 4;
    const int dch = n * 128 + 16 * wv + fr;
    bf16x8 Bf[2][4];
#pragma unroll
    for (int g = 0; g < 2; ++g)
#pragma unroll
        for (int kk = 0; kk < 4; ++kk) Bf[g][kk] = *(const bf16x8*)(((u16*)(F.ws + WS_LW)) + ((size_t)((DIR * 2 + g) * 8 + n) * 128 + 16 * wv + fr) * 128 + kk * 32 + fq * 8);
    f32x4 acc[2][8];
#pragma unroll
    for (int m = 0; m < 8; ++m) { acc[0][m] = (f32x4){0.f, 0.f, 0.f, 0.f}; acc[1][m] = (f32x4){0.f, 0.f, 0.f, 0.f}; }
#pragma unroll
    for (int m = 0; m < 8; ++m)
#pragma unroll
        for (int kk = 0; kk < 4; ++kk) { const bf16x8 a = *(const LAS bf16x8*)(XC + (16 * m + fr) * LP + kk * 32 + fq * 8);
            acc[0][m] = MFMA16(a, Bf[0][kk], acc[0][m]); acc[1][m] = MFMA16(a, Bf[1][kk], acc[1][m]); if (kk == 3 && (m & 1)) __builtin_amdgcn_sched_barrier(0); }
    const float ba = F.lru_ba[DIR * 1024 + dch], bx = F.lru_bx[DIR * 1024 + dch], lam = F.lru_lam[DIR * 1024 + dch];
    const float ls8 = 8.f * logsigf_(lam);
#pragma unroll
    for (int m = 0; m < 8; ++m)
#pragma unroll
        for (int j = 0; j < 4; ++j) { const int t = 16 * m + 4 * fq + j;
            const float xc = bf2f(XC[t * LP + 16 * wv + fr]);
            const float r = sigmoidf_(acc[0][m][j] + ba), ig = sigmoidf_(acc[1][m][j] + bx);
            const float la = ls8 * r; const float a = __expf(la);
            const float x2 = 2.f * la;
            const float om = -x2 * (1.f + 0.5f * x2 * (1.f + (1.f / 3.f) * x2 * (1.f + 0.25f * x2 * (1.f + 0.2f * x2))));
            const float u = __builtin_amdgcn_sqrtf(fmaxf(om, 0.f)) * (ig * xc);
            acc[0][m][j] = a; acc[1][m][j] = u; }
    float TP = 1.f, TH = 0.f;
    const int q = DIR ? 3 - fq : fq;
#pragma unroll
    for (int mm = 0; mm < 8; ++mm) { const int m = DIR ? 7 - mm : mm;
        float p[4], h[4];
#pragma unroll
        for (int k = 0; k < 4; ++k) { const int j = DIR ? 3 - k : k;
            if (k == 0) { p[j] = acc[0][m][j]; h[j] = acc[1][m][j]; }
            else { const int jp = DIR ? j + 1 : j - 1; p[j] = p[jp] * acc[0][m][j]; h[j] = acc[0][m][j] * h[jp] + acc[1][m][j]; } }
        const float aggP = p[DIR ? 0 : 3], aggH = h[DIR ? 0 : 3];
        float cP = 1.f, cH = 0.f;
#pragma unroll
        for (int k = 0; k < 3; ++k) { const int sfq = DIR ? 3 - k : k;
            const float qP = __shfl(aggP, fr + 16 * sfq), qH = __shfl(aggH, fr + 16 * sfq);
            if (k < q) { cH = qP * cH + qH; cP = cP * qP; } }
        float tP = cP * aggP, tH = aggP * cH + aggH;
        tP = __shfl(tP, fr + 16 * (DIR ? 0 : 3)); tH = __shfl(tH, fr + 16 * (DIR ? 0 : 3));
        const float prefP = TP * cP, prefH = cP * TH + cH;
#pragma unroll
        for (int j = 0; j < 4; ++j) { const int t = 16 * m + 4 * fq + j;
            OP[t * LP + 16 * wv + fr] = (u16)f2bf(prefP * p[j]);
            OH[t * LP + 16 * wv + fr] = (u16)f2bf(p[j] * prefH + h[j]); }
        TH = tP * TH + tH; TP = TP * tP;
    }
    if (fq == 0) { float* ag = ((float*)(F.ws + WS_AGG)) + ((size_t)((DIR * 8 + b) * 16 + c) * 1024 + dch) * 2; ag[0] = TP; ag[1] = TH; }
    __syncthreads();
    {
        const size_t m0 = (size_t)b * SEQ + c * 128; const int ch = F.tid & 15;
#pragma unroll
        for (int k = 0; k < 4; ++k) { const int row = (F.tid >> 4) + 32 * k;
            const u32x4 vh = *(const LAS u32x4*)(OH + row * LP + ch * 8), vp = *(const LAS u32x4*)(OP + row * LP + ch * 8);
            const size_t gi = ((size_t)DIR * M + m0 + row) * 1024 + n * 128 + ch * 8;
            *(u32x4*)(((u16*)(F.ws + WS_HL)) + gi) = vh; *(u32x4*)(((u16*)(F.ws + WS_PP)) + gi) = vp; }
    }
    __syncthreads();
}
__device__ __forceinline__ void lru_unit(Frame& F, int u) {
    const int b = u >> 7, c = (u >> 3) & 15, n = u & 7;
    LAS u16* XC = (LAS u16*)F.lds; LAS u16* OH = XC + 128 * LP; LAS u16* OP = OH + 128 * LP;
    {
        const int cgp = F.tid & 15, rg = F.tid >> 4, wch = n * 128 + cgp * 8, t0 = c * 128 + rg * 4;
        float cw[4][8], cb[8]; u32x4 xw[7];
#pragma unroll
        for (int j = 0; j < 4; ++j) { const f32x4 a = *(const f32x4*)(F.conv_w + j * 1024 + wch), bq = *(const f32x4*)(F.conv_w + j * 1024 + wch + 4);
            cw[j][0] = a.x; cw[j][1] = a.y; cw[j][2] = a.z; cw[j][3] = a.w; cw[j][4] = bq.x; cw[j][5] = bq.y; cw[j][6] = bq.z; cw[j][7] = bq.w; }
        { const f32x4 a = *(const f32x4*)(F.conv_b + wch), bq = *(const f32x4*)(F.conv_b + wch + 4);
            cb[0] = a.x; cb[1] = a.y; cb[2] = a.z; cb[3] = a.w; cb[4] = bq.x; cb[5] = bq.y; cb[6] = bq.z; cb[7] = bq.w; }
#pragma unroll
        for (int rr = 0; rr < 7; ++rr) { const int t = t0 - 2 + rr;
            xw[rr] = (u32x4){0u, 0u, 0u, 0u};
            if (t >= 0 && t < SEQ) xw[rr] = *(const u32x4*)(((u16*)(F.ws + WS_BIG)) + ((size_t)b * SEQ + t) * EVEN_IN + C_XL + wch); }
#pragma unroll
        for (int r = 0; r < 4; ++r) { float o[8];
#pragma unroll
            for (int e = 0; e < 8; ++e) o[e] = cb[e];
#pragma unroll
            for (int j = 0; j < 4; ++j) { const u32x4 w = xw[r + j];
                o[0] += lo16(w.x) * cw[j][0]; o[1] += hi16(w.x) * cw[j][1]; o[2] += lo16(w.y) * cw[j][2]; o[3] += hi16(w.y) * cw[j][3];
                o[4] += lo16(w.z) * cw[j][4]; o[5] += hi16(w.z) * cw[j][5]; o[6] += lo16(w.w) * cw[j][6]; o[7] += hi16(w.w) * cw[j][7]; }
            u32x4 w; w.x = pk2(o[0], o[1]); w.y = pk2(o[2], o[3]); w.z = pk2(o[4], o[5]); w.w = pk2(o[6], o[7]);
            *(LAS u32x4*)(XC + (rg * 4 + r) * LP + cgp * 8) = w; }
    }
    __syncthreads();
    lru_dir<0>(F, b, c, n, XC, OH, OP);
    lru_dir<1>(F, b, c, n, XC, OH, OP);
}

__device__ __forceinline__ void lru_apply_unit(Frame& F, int u) {
    const int b = u >> 6, c = (u >> 2) & 15, q4 = u & 3, w2 = 2 * F.tid;
    LAS float* CF = (LAS float*)F.lds; LAS float* CB = CF + 1024;
    {
        float cf0 = 0.f, cf1 = 0.f, cb0 = 0.f, cb1 = 0.f;
#pragma unroll 8
        for (int k = 0; k < 16; ++k) { const f32x4 a = *(const f32x4*)(((float*)(F.ws + WS_AGG)) + ((size_t)((0 * 8 + b) * 16 + k) * 1024 + w2) * 2);
            if (k < c) { cf0 = a.x * cf0 + a.y; cf1 = a.z * cf1 + a.w; } }
#pragma unroll 8
        for (int k = 15; k >= 0; --k) { const f32x4 a = *(const f32x4*)(((float*)(F.ws + WS_AGG)) + ((size_t)((1 * 8 + b) * 16 + k) * 1024 + w2) * 2);
            if (k > c) { cb0 = a.x * cb0 + a.y; cb1 = a.z * cb1 + a.w; } }
        CF[w2] = cf0; CF[w2 + 1] = cf1; CB[w2] = cb0; CB[w2 + 1] = cb1;
    }
    __syncthreads();
    {
        const int chg = F.tid & 127, rsub = F.tid >> 7;
        float cf[8], cb[8];
        { const f32x4 a0 = *(const LAS f32x4*)(CF + 8 * chg), a1 = *(const LAS f32x4*)(CF + 8 * chg + 4), b0 = *(const LAS f32x4*)(CB + 8 * chg), b1 = *(const LAS f32x4*)(CB + 8 * chg + 4);
            cf[0] = a0.x; cf[1] = a0.y; cf[2] = a0.z; cf[3] = a0.w; cf[4] = a1.x; cf[5] = a1.y; cf[6] = a1.z; cf[7] = a1.w;
            cb[0] = b0.x; cb[1] = b0.y; cb[2] = b0.z; cb[3] = b0.w; cb[4] = b1.x; cb[5] = b1.y; cb[6] = b1.z; cb[7] = b1.w; }
#pragma unroll 4
        for (int i = 0; i < 8; ++i) { const size_t m = (size_t)b * SEQ + c * 128 + q4 * 32 + rsub + 4 * i; const size_t idx = m * 1024 + 8 * chg;
            const u32x4 hf = *(const u32x4*)(((u16*)(F.ws + WS_HL)) + idx), pf = *(const u32x4*)(((u16*)(F.ws + WS_PP)) + idx);
            const u32x4 hb = *(const u32x4*)(((u16*)(F.ws + WS_HL)) + (size_t)M * 1024 + idx), pb = *(const u32x4*)(((u16*)(F.ws + WS_PP)) + (size_t)M * 1024 + idx);
            const u32x4 gl = *(const u32x4*)(((u16*)(F.ws + WS_BIG)) + m * EVEN_IN + C_GL + 8 * chg);
            u32x4 o;
#pragma unroll
            for (int e = 0; e < 4; ++e) {
                const float y0 = lo16(hf[e]) + lo16(pf[e]) * cf[2 * e] + lo16(hb[e]) + lo16(pb[e]) * cb[2 * e];
                const float y1 = hi16(hf[e]) + hi16(pf[e]) * cf[2 * e + 1] + hi16(hb[e]) + hi16(pb[e]) * cb[2 * e + 1];
                o[e] = pg8::cvt_pk_bf16(y0 * siluf_(lo16(gl[e])), y1 * siluf_(hi16(gl[e]))); }
            *(u32x4*)(((u16*)(F.ws + WS_MIX)) + m * DM + 1024 + 8 * chg) = o; }
    }
    __syncthreads();
}
__device__ __forceinline__ void attn_unit(Frame& F, int u) {
    int b = u >> 6, h = (u >> 3) & 7, qb = u & 7;
    if (F.G == 256) { const int x = blockIdx.x & 7, j = (blockIdx.x >> 3) + 32 * (u >> 8); b = x; h = j >> 3; qb = j & 7; }
    const int kvh = h >> 2;
    const size_t row0 = (size_t)b * SEQ + qb * 256, rowb = (size_t)b * SEQ;
    att::attn_dense_body<att::bf16>((const att::bf16*)(((u16*)(F.ws + WS_BIG)) + row0 * EVEN_IN + C_Q + h * 128), (const att::bf16*)(((u16*)(F.ws + WS_BIG)) + rowb * EVEN_IN + C_K + kvh * 128),
                                    (const att::bf16*)(((u16*)(F.ws + WS_BIG)) + rowb * EVEN_IN + C_V + kvh * 128), ((u16*)(F.ws + WS_MIX)) + row0 * DM + h * 128,
                                    ((u16*)(F.ws + WS_BIG)) + row0 * EVEN_IN + C_GA + h * 128, SEQ, F.lds_g);
    __syncthreads();
}

__device__ __forceinline__ void gates_finish(Frame& F, int r0, f32x4 a0, f32x4 a1) {
    const int fr = F.lane & 15, fq = F.lane >> 4;
    const float bi0 = F.gate_bias[fr], bi1 = F.gate_bias[16 + fr];
#pragma unroll
    for (int j = 0; j < 4; ++j) { float* g = ((float*)(F.ws + WS_GATES)) + (size_t)(r0 + 4 * fq + j) * 32;
        const float rsc = rsqrtf(((const float*)(F.ws + WS_SUMSQ))[r0 + 4 * fq + j] * (1.f / 2048.f) + EPS);
        g[fr] = a0[j] * rsc + bi0; g[16 + fr] = logsigf_(a1[j] * rsc + bi1); }
}
__device__ __forceinline__ void gates_partial(Frame& F, int r0, int kk0, int nkk, f32x4& a0, f32x4& a1) {
    const int lane = F.lane, fr = lane & 15, fq = lane >> 4;
    a0 = (f32x4){0.f, 0.f, 0.f, 0.f}; a1 = a0;
    const u16* ap = ((u16*)(F.ws + WS_XN)) + (size_t)(r0 + fr) * DM + fq * 8 + kk0 * 32; const u16* bp0 = ((u16*)(F.ws + WS_WG1T)) + (size_t)fr * DM + fq * 8 + kk0 * 32; const u16* bp1 = bp0 + 16 * DM;
#pragma unroll 8
    for (int kk = 0; kk < nkk; ++kk) { const bf16x8 a = *(const bf16x8*)(ap + kk * 32);
        a0 = MFMA16(a, *(const bf16x8*)(bp0 + kk * 32), a0); a1 = MFMA16(a, *(const bf16x8*)(bp1 + kk * 32), a1); }
}
__device__ __forceinline__ void gates_task(Frame& F, int task) { f32x4 a0, a1; gates_partial(F, task * 16, 0, 64, a0, a1); gates_finish(F, task * 16, a0, a1); }
constexpr int GWP = 2056;
__device__ __forceinline__ void gates_phase_split(Frame& F) {
    LAS u16* Bs = (LAS u16*)F.lds;
    for (int i = F.tid; i < 32 * 256; i += NWAVES * 64) { const int row = i >> 8, ch = i & 255;
        *(LAS u32x4*)(Bs + row * GWP + ch * 8) = *(const u32x4*)(((u16*)(F.ws + WS_WG1T)) + (size_t)row * DM + ch * 8); }
    __syncthreads();
    const int task = F.gw >> 1, half = F.wave & 1, lane = F.lane, fr = lane & 15, fq = lane >> 4, r0 = task * 16;
    f32x4 a0 = (f32x4){0.f, 0.f, 0.f, 0.f}, a1 = a0;
    const u16* ap = ((u16*)(F.ws + WS_XN)) + (size_t)(r0 + fr) * DM + fq * 8 + half * 1024;
    const LAS u16* bp0 = Bs + fr * GWP + fq * 8 + half * 1024; const LAS u16* bp1 = bp0 + 16 * GWP;
    {   bf16x8 av[32];
#pragma unroll
        for (int kk = 0; kk < 32; ++kk) av[kk] = *(const bf16x8*)(ap + kk * 32);
#pragma unroll
        for (int kk = 0; kk < 32; ++kk) { a0 = MFMA16(av[kk], *(const LAS bf16x8*)(bp0 + kk * 32), a0); a1 = MFMA16(av[kk], *(const LAS bf16x8*)(bp1 + kk * 32), a1); } }
    __syncthreads();
    LAS f32x4* X = (LAS f32x4*)F.lds + (F.wave >> 1) * 128 + lane;
    if (half) { X[0] = a0; X[64] = a1; }
    __syncthreads();
    if (!half) { a0 = a0 + X[0]; a1 = a1 + X[64]; gates_finish(F, r0, a0, a1); }
}

__device__ __forceinline__ void mlstm_unit(Frame& F, int u, u16* Hout) {
    const int b = u >> 5, h = (u >> 2) & 7, dir = (u >> 1) & 1, vh = u & 1;
    const int tid = F.tid, wv = tid >> 6, lane = F.lane, fr = lane & 15, fq = lane >> 4;
    const int rg = wv >> 1, ch = wv & 1;
    LAS u16* Ks = (LAS u16*)F.lds; LAS u16* Ktw = Ks + 128 * LP; LAS u16* Vt = Ktw + 128 * LP; LAS u16* Cb = Vt + 128 * LP;
    LAS float* Gs = (LAS float*)(Cb + 144 * LP); LAS float* MMs = Gs + 128; LAS float* MTs = MMs + 128; LAS float* Ns = MTs + 128; LAS float* SCs = Ns + 128; LAS float* RSs = SCs + 16;
    for (int i = tid; i < 144 * LP / 2; i += NWAVES * 64) ((LAS unsigned*)Cb)[i] = 0u;
    if (tid < 128) Ns[tid] = 0.f;
    f32x4 Cacc[2][4];
#pragma unroll
    for (int mt = 0; mt < 2; ++mt)
#pragma unroll
        for (int nt = 0; nt < 4; ++nt) Cacc[mt][nt] = (f32x4){0.f, 0.f, 0.f, 0.f};
    float mstate = 0.f;
    const u16* P1 = ((u16*)(F.ws + WS_BIG));
#define GROWC(cc, i) ((size_t)b * SEQ + (size_t)(dir ? (SEQ - 1 - (128 * (cc) + (i))) : (128 * (cc) + (i))))
#define GROW(i) GROWC(c, i)
    const int r0 = 2 * lane, r1 = 2 * lane + 1;
    bf16x8 kA[2], kB[2], vA[2], vB[2];
    float gi0 = 0.f, gi1 = 0.f, gf0 = 0.f, gf1 = 0.f;
#define MLOAD(cc) do { const size_t g0_ = GROWC(cc, r0), g1_ = GROWC(cc, r1); \
        _Pragma("unroll") for (int k = 0; k < 2; ++k) { const int col = (wv + 8 * k) * 8; \
            kA[k] = *(const bf16x8*)(P1 + g0_ * ODD_MAIN + D_K + h * 128 + col); kB[k] = *(const bf16x8*)(P1 + g1_ * ODD_MAIN + D_K + h * 128 + col); \
            vA[k] = *(const bf16x8*)(P1 + g0_ * ODD_MAIN + D_V + h * 256 + vh * 128 + col); vB[k] = *(const bf16x8*)(P1 + g1_ * ODD_MAIN + D_V + h * 256 + vh * 128 + col); } \
        if (wv == 0) { const float* G0 = ((float*)(F.ws + WS_GATES)) + g0_ * 32; const float* G1 = ((float*)(F.ws + WS_GATES)) + g1_ * 32; \
            gi0 = G0[dir * 8 + h]; gi1 = G1[dir * 8 + h]; gf0 = G0[16 + dir * 8 + h]; gf1 = G1[16 + dir * 8 + h]; } } while (0)
    MLOAD(0);
    for (int c = 0; c < 16; ++c) {
        bf16x8 Qf[2][4];
#pragma unroll
        for (int mt = 0; mt < 2; ++mt) { const size_t gq_ = GROW(32 * rg + 16 * mt + fr);
#pragma unroll
            for (int kk = 0; kk < 4; ++kk) Qf[mt][kk] = *(const bf16x8*)(P1 + gq_ * ODD_MAIN + D_Q + h * 128 + kk * 32 + fq * 8); }
        if (wv == 0) {
            const float i0 = gi0, i1 = gi1, f0 = gf0, f1 = gf1;
            const float s = f0 + f1; float incl = s;
#pragma unroll
            for (int o = 1; o < 64; o <<= 1) { const float t = __shfl_up(incl, o); if (lane >= o) incl += t; }
            const float b0 = incl - s + f0, b1 = incl;
            const float gg0 = i0 - b0, gg1 = i1 - b1;
            float inclm = fmaxf(gg0, gg1);
#pragma unroll
            for (int o = 1; o < 64; o <<= 1) { const float t = __shfl_up(inclm, o); if (lane >= o) inclm = fmaxf(inclm, t); }
            float exclm = __shfl_up(inclm, 1); if (lane == 0) exclm = -INFINITY;
            const float cm0 = fmaxf(exclm, gg0), cm1 = fmaxf(cm0, gg1);
            const float M0 = fmaxf(mstate, cm0), M1 = fmaxf(mstate, cm1);
            Gs[r0] = gg0; Gs[r1] = gg1; MMs[r0] = M0; MMs[r1] = M1; MTs[r0] = b0 + M0; MTs[r1] = b1 + M1;
            const float blast = __shfl(b1, 63), M127 = __shfl(M1, 63);
            if (lane == 0) { SCs[0] = mstate; SCs[1] = M127; }
            mstate = blast + M127;
        }
        __syncthreads();
        const float mold = SCs[0], M127 = SCs[1];
        const float decay = __expf(mold - M127);
        {   const float ws0 = __expf(Gs[r0] - M127), ws1 = __expf(Gs[r1] - M127);
#pragma unroll
            for (int k = 0; k < 2; ++k) { const int col = (wv + 8 * k) * 8;
                *(LAS bf16x8*)(Ks + r0 * LP + col) = kA[k]; *(LAS bf16x8*)(Ks + r1 * LP + col) = kB[k];
#pragma unroll
                for (int e = 0; e < 8; ++e) {
                    const float ka = bf2f((u16)kA[k][e]) * ws0, kb = bf2f((u16)kB[k][e]) * ws1;
                    ((LAS unsigned*)(Ktw + (col + e) * LP))[lane] = pg8::cvt_pk_bf16(ka, kb);
                    ((LAS unsigned*)(Vt + (col + e) * LP))[lane] = (unsigned)(u16)vA[k][e] | ((unsigned)(u16)vB[k][e] << 16); } }
        }
        { const int cn = c < 15 ? c + 1 : 15; MLOAD(cn); }
        __syncthreads();
        f32x4 S[2][4], N[2][4], N8[2];
#pragma unroll
        for (int mt = 0; mt < 2; ++mt) { N8[mt] = (f32x4){0.f, 0.f, 0.f, 0.f};
#pragma unroll
            for (int nt = 0; nt < 4; ++nt) { S[mt][nt] = (f32x4){0.f, 0.f, 0.f, 0.f}; N[mt][nt] = (f32x4){0.f, 0.f, 0.f, 0.f}; } }
#pragma unroll
        for (int nt = 0; nt < 4; ++nt)
#pragma unroll
            for (int kk = 0; kk < 4; ++kk) {
                const bf16x8 kf = *(const LAS bf16x8*)(Ks + (64 * ch + 16 * nt + fr) * LP + kk * 32 + fq * 8);
                const bf16x8 cf = *(const LAS bf16x8*)(Cb + (64 * ch + 16 * nt + fr) * LP + kk * 32 + fq * 8);
#pragma unroll
                for (int mt = 0; mt < 2; ++mt) { S[mt][nt] = MFMA16(kf, Qf[mt][kk], S[mt][nt]);
                    N[mt][nt] = MFMA16(cf, Qf[mt][kk], N[mt][nt]); } }
#pragma unroll
        for (int kk = 0; kk < 4; ++kk) { const bf16x8 nf = *(const LAS bf16x8*)(Cb + (128 + fr) * LP + kk * 32 + fq * 8);
#pragma unroll
            for (int mt = 0; mt < 2; ++mt) N8[mt] = MFMA16(nf, Qf[mt][kk], N8[mt]); }
        float Ml[2], inter[2], qn[2], rs[2];
#pragma unroll
        for (int mt = 0; mt < 2; ++mt) { const int l = 32 * rg + 16 * mt + fr; Ml[mt] = MMs[l]; inter[mt] = __expf(mold - Ml[mt]); qn[mt] = __shfl(N8[mt][0], fr); rs[mt] = 0.f; }
#pragma unroll
        for (int nt = 0; nt < 4; ++nt) { const f32x4 g4 = *(const LAS f32x4*)(Gs + 64 * ch + 16 * nt + 4 * fq);
#pragma unroll
            for (int mt = 0; mt < 2; ++mt) { const int l = 32 * rg + 16 * mt + fr;
#pragma unroll
                for (int j = 0; j < 4; ++j) { const int sidx = 64 * ch + 16 * nt + 4 * fq + j;
                    const float dm = (sidx <= l) ? __expf(g4[j] - Ml[mt]) : 0.f; const float sc = S[mt][nt][j] * dm; S[mt][nt][j] = sc; rs[mt] += sc; } } }
#pragma unroll
        for (int mt = 0; mt < 2; ++mt) { rs[mt] += __shfl_xor(rs[mt], 16); rs[mt] += __shfl_xor(rs[mt], 32);
            if (fq == 0) RSs[(32 * rg + 16 * mt + fr) * 2 + ch] = rs[mt]; }
        __syncthreads();
#pragma unroll
        for (int mt = 0; mt < 2; ++mt)
#pragma unroll
            for (int nt = 0; nt < 4; ++nt) { u32x2 w; w.x = pg8::cvt_pk_bf16(S[mt][nt][0], S[mt][nt][1]); w.y = pg8::cvt_pk_bf16(S[mt][nt][2], S[mt][nt][3]);
                *(LAS u32x2*)(Ks + (32 * rg + 16 * mt + fr) * LP + 64 * ch + 16 * nt + 4 * fq) = w; }
        __syncthreads();
#pragma unroll
        for (int mt = 0; mt < 2; ++mt)
#pragma unroll
            for (int nt = 0; nt < 4; ++nt) N[mt][nt] = N[mt][nt] * inter[mt];
        {   bf16x8 Af[2][4];
#pragma unroll
            for (int mt = 0; mt < 2; ++mt)
#pragma unroll
                for (int kk = 0; kk < 4; ++kk) Af[mt][kk] = *(const LAS bf16x8*)(Ks + (32 * rg + 16 * mt + fr) * LP + kk * 32 + fq * 8);
#pragma unroll
            for (int nt = 0; nt < 4; ++nt)
#pragma unroll
                for (int kk = 0; kk < 4; ++kk) { const bf16x8 vf = *(const LAS bf16x8*)(Vt + (64 * ch + 16 * nt + fr) * LP + kk * 32 + fq * 8);
#pragma unroll
                    for (int mt = 0; mt < 2; ++mt) N[mt][nt] = MFMA16(vf, Af[mt][kk], N[mt][nt]); }
        }
#pragma unroll
        for (int mt = 0; mt < 2; ++mt) { const int l = 32 * rg + 16 * mt + fr;
            const float den = RSs[2 * l] + RSs[2 * l + 1] + inter[mt] * qn[mt];
            const float inv = __builtin_amdgcn_rcpf(fmaxf(fabsf(den), __expf(-MTs[l])));
            u16* orow = Hout + GROW(l) * DM + h * 256 + vh * 128 + 64 * ch + 4 * fq;
#pragma unroll
            for (int nt = 0; nt < 4; ++nt) { u32x2 w; w.x = pg8::cvt_pk_bf16(N[mt][nt][0] * inv, N[mt][nt][1] * inv); w.y = pg8::cvt_pk_bf16(N[mt][nt][2] * inv, N[mt][nt][3] * inv);
                *(u32x2*)(orow + 16 * nt) = w; } }
#pragma unroll
        for (int mt = 0; mt < 2; ++mt)
#pragma unroll
            for (int nt = 0; nt < 4; ++nt) Cacc[mt][nt] = Cacc[mt][nt] * decay;
        {   bf16x8 Vf[2][4];
#pragma unroll
            for (int mt = 0; mt < 2; ++mt)
#pragma unroll
                for (int kk = 0; kk < 4; ++kk) Vf[mt][kk] = *(const LAS bf16x8*)(Vt + (32 * rg + 16 * mt + fr) * LP + kk * 32 + fq * 8);
#pragma unroll
            for (int nt = 0; nt < 4; ++nt)
#pragma unroll
                for (int kk = 0; kk < 4; ++kk) { const bf16x8 kf = *(const LAS bf16x8*)(Ktw + (64 * ch + 16 * nt + fr) * LP + kk * 32 + fq * 8);
#pragma unroll
                    for (int mt = 0; mt < 2; ++mt) Cacc[mt][nt] = MFMA16(kf, Vf[mt][kk], Cacc[mt][nt]); }
        }
        float nnew = 0.f;
        if (tid < 128) { float sum = 0.f;
#pragma unroll
            for (int s8 = 0; s8 < 16; ++s8) { const u32x4 w = *(const LAS u32x4*)(Ktw + tid * LP + s8 * 8);
                sum += (lo16(w.x) + hi16(w.x)) + (lo16(w.y) + hi16(w.y)) + (lo16(w.z) + hi16(w.z)) + (lo16(w.w) + hi16(w.w)); }
            nnew = decay * Ns[tid] + sum; }
        __syncthreads();
#pragma unroll
        for (int mt = 0; mt < 2; ++mt)
#pragma unroll
            for (int nt = 0; nt < 4; ++nt) { u32x2 w; w.x = pg8::cvt_pk_bf16(Cacc[mt][nt][0], Cacc[mt][nt][1]); w.y = pg8::cvt_pk_bf16(Cacc[mt][nt][2], Cacc[mt][nt][3]);
                *(LAS u32x2*)(Cb + (32 * rg + 16 * mt + fr) * LP + 64 * ch + 16 * nt + 4 * fq) = w; }
        if (tid < 128) { Ns[tid] = nnew; Cb[128 * LP + tid] = (u16)f2bf(nnew); }
    }
#undef GROW
#undef GROWC
#undef MLOAD
    __syncthreads();
}

__device__ __forceinline__ void combine_token(Frame& F, int m, const u16* HF, const u16* HBMIX, u16* DST, size_t didx_mask) {
    const int lane = F.lane, half = lane >> 5, i8 = (lane & 31) * 8;
    const size_t idx = (size_t)m * DM + half * 256 + i8; const u16* pz = ((u16*)(F.ws + WS_BIG)) + (size_t)m * ODD_MAIN + half * 256 + i8;
    u32x4 hf[4], hb[4], ov[4], zv[4];
#pragma unroll
    for (int hp = 0; hp < 4; ++hp) { hf[hp] = *(const u32x4*)(HF + idx + hp * 512); hb[hp] = *(const u32x4*)(HBMIX + idx + hp * 512);
        ov[hp] = *(const u32x4*)(pz + D_O + hp * 512); zv[hp] = *(const u32x4*)(pz + D_Z + hp * 512); }
#pragma unroll
    for (int hp = 0; hp < 4; ++hp) {
        const f32x4 g0 = *(const f32x4*)(F.norm1 + hp * 512 + half * 256 + i8), g1 = *(const f32x4*)(F.norm1 + hp * 512 + half * 256 + i8 + 4);
        float v[8]; float ss = 0.f;
#pragma unroll
        for (int e = 0; e < 4; ++e) { v[2 * e] = sigmoidf_(lo16(ov[hp][e])) * (lo16(hf[hp][e]) + lo16(hb[hp][e])); v[2 * e + 1] = sigmoidf_(hi16(ov[hp][e])) * (hi16(hf[hp][e]) + hi16(hb[hp][e]));
            ss += v[2 * e] * v[2 * e] + v[2 * e + 1] * v[2 * e + 1]; }
#pragma unroll
        for (int o = 1; o < 32; o <<= 1) ss += __shfl_xor(ss, o);
        const float r = rsqrtf(ss * (1.f / 256.f) + EPS);
        u32x4 o;
        o[0] = pg8::cvt_pk_bf16(v[0] * r * g0.x * siluf_(lo16(zv[hp][0])), v[1] * r * g0.y * siluf_(hi16(zv[hp][0])));
        o[1] = pg8::cvt_pk_bf16(v[2] * r * g0.z * siluf_(lo16(zv[hp][1])), v[3] * r * g0.w * siluf_(hi16(zv[hp][1])));
        o[2] = pg8::cvt_pk_bf16(v[4] * r * g1.x * siluf_(lo16(zv[hp][2])), v[5] * r * g1.y * siluf_(hi16(zv[hp][2])));
        o[3] = pg8::cvt_pk_bf16(v[6] * r * g1.z * siluf_(lo16(zv[hp][3])), v[7] * r * g1.w * siluf_(hi16(zv[hp][3])));
        *(u32x4*)(DST + ((idx + hp * 512) & didx_mask)) = o; }
}
__device__ __forceinline__ void final_row(const u16* row, float ss, float* drow, const float* gain, int lane) {
    const unsigned long long* xr = (const unsigned long long*)row + lane; f32x4* dr = (f32x4*)drow + lane; const f32x4* gr = (const f32x4*)gain + lane;
    const float r = rsqrtf(ss * (1.f / DM) + EPS);
    unsigned long long w[8];
#pragma unroll
    for (int j = 0; j < 8; ++j) w[j] = xr[64 * j];
#pragma unroll
    for (int j = 0; j < 8; ++j) { const f32x4 g = gr[64 * j]; const unsigned lo = (unsigned)w[j], hi = (unsigned)(w[j] >> 32);
        dr[64 * j] = (f32x4){lo16(lo) * r * g.x, hi16(lo) * r * g.y, lo16(hi) * r * g.z, hi16(hi) * r * g.w}; }
}

#define XB_TMO      128
#define XB_XCNT(j)  (256  + 64 * (j))
#define XB_XSUB(j)  (1280 + 64 * (j))
#define XB_XGEN(j)  (2304 + 64 * (j))
#define XB_TOP      3328
#define XB_TOPGEN   3392
#define XCD_BAR_WORDS 3456
#define XB_SPIN_CAP (1u << 18)

__device__ __forceinline__ unsigned xb_ld(unsigned* p)              { return __hip_atomic_load(p, __ATOMIC_RELAXED, __HIP_MEMORY_SCOPE_AGENT); }
__device__ __forceinline__ unsigned xb_add(unsigned* p, unsigned v) { return __hip_atomic_fetch_add(p, v, __ATOMIC_RELAXED, __HIP_MEMORY_SCOPE_AGENT); }
__device__ __forceinline__ unsigned xb_xcc_id() { return (unsigned)__builtin_amdgcn_s_getreg((3 << 11) | 20) & 0xFu; }
#define XB_SPIN(cond, bar) do { unsigned _sp = 0; while (cond) { __builtin_amdgcn_s_sleep(1); \
    if ((++_sp & 255u) == 0u) { if (xb_ld(&(bar)[XB_TMO])) break; if (_sp > XB_SPIN_CAP) { atomicAdd(&(bar)[XB_TMO], 1u); break; } } } } while (0)

struct XcdBarrier {
    unsigned* bar; unsigned x;
    volatile LAS unsigned* st;
};

__device__ __forceinline__ XcdBarrier xcd_barrier_post(unsigned* bar, volatile LAS unsigned* st) {
    XcdBarrier b; b.bar = bar; b.x = xb_xcc_id(); b.st = st;
    if (threadIdx.x == 0) (void)xb_add(&bar[XB_XCNT(b.x)], 1u);
    return b;
}
__device__ __forceinline__ void xcd_barrier_complete(unsigned* bar, unsigned x, unsigned& nloc, unsigned& nx) {
    const unsigned G = gridDim.x * gridDim.y * gridDim.z;
    unsigned sum, cnt, mine, sp = 0u;
    for (;;) {
        sum = 0u; cnt = 0u; mine = 0u;
#pragma unroll
        for (unsigned j = 0; j < 16; ++j) { const unsigned c = xb_ld(&bar[XB_XCNT(j)]); sum += c; cnt += (c > 0u) ? 1u : 0u; mine = (j == x) ? c : mine; }
        if (sum == G) break;
        __builtin_amdgcn_s_sleep(1);
        if ((++sp & 255u) == 0u) { if (xb_ld(&bar[XB_TMO])) break; if (sp > XB_SPIN_CAP) { atomicAdd(&bar[XB_TMO], 1u); break; } }
    }
    nloc = mine > 0u ? mine : 1u; nx = cnt > 0u ? cnt : 1u;
}

__device__ __forceinline__ void xcd_barrier(const XcdBarrier& b) {
    asm volatile("s_waitcnt vmcnt(0)" ::: "memory");
    __syncthreads();
    if (threadIdx.x == 0) {
        unsigned* bar = b.bar;
        __builtin_amdgcn_s_waitcnt(0);
        unsigned nloc = b.st[0], nx = b.st[1];
        if (nloc == 0u) { xcd_barrier_complete(bar, b.x, nloc, nx); b.st[0] = nloc; b.st[1] = nx; }
        const unsigned old = xb_add(&bar[XB_XSUB(b.x)], 1u);
        const unsigned gen = old / nloc;
        if (old + 1u == (gen + 1u) * nloc) {
            __builtin_amdgcn_fence(__ATOMIC_RELEASE, "agent");
            asm volatile("s_waitcnt vmcnt(0)" ::: "memory");
            const unsigned og = xb_add(&bar[XB_TOP], 1u);
            const unsigned tg = og / nx;
            if (og + 1u == (tg + 1u) * nx) xb_add(&bar[XB_TOPGEN], 1u);
            else XB_SPIN(xb_ld(&bar[XB_TOPGEN]) == tg, bar);
            __builtin_amdgcn_fence(__ATOMIC_ACQUIRE, "agent");
            xb_add(&bar[XB_XGEN(b.x)], 1u);
            asm volatile("s_waitcnt vmcnt(0)" ::: "memory");
        } else {
            XB_SPIN(xb_ld(&bar[XB_XGEN(b.x)]) == gen, bar);
            __builtin_amdgcn_fence(__ATOMIC_ACQUIRE, "agent");
            asm volatile("s_waitcnt vmcnt(0)" ::: "memory");
        }
    }
    __syncthreads();
}
__global__ void __launch_bounds__(NWAVES * 64, 2) fwd_megakernel(Args args) {
    extern __shared__ __attribute__((aligned(16))) unsigned char lds[];
    cg::grid_group grid = cg::this_grid();
    Frame F;
    F.lds = (LAS unsigned char*)lds; F.lds_g = (char*)lds;
    F.tid = threadIdx.x; F.lane = F.tid & 63; F.wave = __builtin_amdgcn_readfirstlane(F.tid >> 6);
    F.G = gridDim.x; F.gw = blockIdx.x * NWAVES + F.wave; F.NGW = F.G * NWAVES;
    F.x = args.in[0]; F.norm_gain = args.in[1]; F.final_gain = args.in[2]; F.w_in0 = args.in[3]; F.w_out0 = args.in[4]; F.qg = args.in[5]; F.kg = args.in[6];
    F.conv_w = args.in[7]; F.conv_b = args.in[8]; F.lru_wa = args.in[9]; F.lru_ba = args.in[10]; F.lru_wx = args.in[11]; F.lru_bx = args.in[12]; F.lru_lam = args.in[13];
    F.w_in1 = args.in[14]; F.gate_bias = args.in[15]; F.norm1 = args.in[16]; F.w_out1 = args.in[17]; F.out = args.out; F.ws = args.ws;
    const int lo = args.ph_lo, hi = args.ph_hi;
    if (F.tid < 16) ((LAS unsigned*)(F.lds + LDS_MISC))[F.tid] = 0u;
    __syncthreads();
    const XcdBarrier xbar = xcd_barrier_post((unsigned*)(args.ws + WS_CTL), (volatile LAS unsigned*)(F.lds + LDS_MISC));
#ifndef PH_MASK
#define PH_MASK 0x7ff
#endif
#define IN(k) ((((PH_MASK) >> (k)) & 1) && lo <= (k) && (k) < hi)
#ifndef XTRA_XB
#define XTRA_XB 0
#endif
#define SEAM(k) do { if (IN(k) && IN((k) + 1)) { xcd_barrier(xbar); if ((k) == 4) for (int xx_ = 0; xx_ < XTRA_XB; ++xx_) xcd_barrier(xbar); } } while (0)
#ifndef DUP_MASK
#define DUP_MASK 0
#endif
#ifndef EXTRA_SYNCS
#define EXTRA_SYNCS 0
#endif
#define REPS(k) for (int rep_ = 0; rep_ < 1 + (((DUP_MASK) >> (k)) & 1); ++rep_)
#define REPSYNC() do { if (rep_) xcd_barrier(xbar); } while (0)
    for (int es_ = (lo < 0 ? -1 : 0); es_ < EXTRA_SYNCS; ++es_) grid.sync();

    if (IN(0)) REPS(0) { REPSYNC(); p0_prologue(F); __syncthreads(); }
    SEAM(0);
    if (IN(1)) {
        pg8::Gemm g{((u16*)(F.ws + WS_XN)), ((u16*)(F.ws + WS_W0T)), M, EVEN_IN, DM}; pg8::StaticOrder S; S.init(M, EVEN_IN, F.G, (int)blockIdx.x);
        pg8::EpiBf16S E{((u16*)(F.ws + WS_BIG)), EVEN_IN, 0, 0, 1.f, nullptr};
        pg8::gemm_phase<pg8::EpiBf16S, pg8::StaticOrder, true, PG8_SP2>(F.lds, g, S, E);
        if (F.G == 256 && blockIdx.x >= 128) { __syncthreads(); p1_deferred(F); __syncthreads(); }
    }
    SEAM(1);
    if (IN(2)) {
        qk_norm_rope(F);
        for (int u = blockIdx.x; u < 1024; u += F.G) lru_unit(F, u);
    }
    SEAM(2);
    if (IN(3)) {
        REPS(3) { REPSYNC(); for (int u = blockIdx.x; u < 512; u += F.G) attn_unit(F, u); }
        REPS(11) { REPSYNC(); for (int u = blockIdx.x; u < 512; u += F.G) lru_apply_unit(F, u); }
        __syncthreads();
    }
    SEAM(3);
    if (IN(4)) REPS(4) { REPSYNC();
        pg8::Gemm g{((u16*)(F.ws + WS_MIX)), ((u16*)(F.ws + WS_WO0T)), M, DM, DM}; pg8::StaticOrder S; S.init(M, DM, F.G, (int)blockIdx.x);
        pg8::EpiResNormB E{((u16*)(F.ws + WS_XN)), DM, F.norm_gain, F.norm_gain + DM, (const float*)(F.ws + WS_SUMSQ) + 3 * M, (float*)(F.ws + WS_SUMSQ)};
        pg8::gemm_phase<pg8::EpiResNormB, pg8::StaticOrder, true, PG8_SP2>(F.lds, g, S, E);
    }
    SEAM(4);
    if (IN(6) && (((DUP_MASK) >> 12) & 1)) {
        pg8::Gemm g{((u16*)(F.ws + WS_XN)), ((u16*)(F.ws + WS_W1T)), M, ODD_MAIN, DM}; pg8::StaticOrder S; S.init(M, ODD_MAIN, F.G, (int)blockIdx.x);
        pg8::EpiBf16S E{((u16*)(F.ws + WS_BIG)), ODD_MAIN, 4, 8, 0.088388347648318440f, (const float*)(F.ws + WS_SUMSQ)};
        pg8::gemm_phase<pg8::EpiBf16S, pg8::StaticOrder, true, PG8_SP2>(F.lds, g, S, E);
        xcd_barrier(xbar);
    }
    if (IN(4) && (((DUP_MASK) >> 13) & 1)) {
        pg8::Gemm g{((u16*)(F.ws + WS_MIX)), ((u16*)(F.ws + WS_WO0T)), M, DM, DM}; pg8::StaticOrder S; S.init(M, DM, F.G, (int)blockIdx.x);
        pg8::EpiResNorm E{F.x, nullptr, DM, F.norm_gain + DM, ((u16*)(F.ws + WS_XN)), (float*)(F.ws + WS_SUMSQ) + 2 * M};
        pg8::gemm_phase<pg8::EpiResNorm, pg8::StaticOrder, true, PG8_SP2>(F.lds, g, S, E);
        xcd_barrier(xbar);
    }
    if (IN(6)) REPS(6) { REPSYNC();
        if (F.G == 256) gates_phase_split(F); else for (int t = F.gw; t < M / 16; t += F.NGW) gates_task(F, t);
        __syncthreads();
        pg8::Gemm g{((u16*)(F.ws + WS_XN)), ((u16*)(F.ws + WS_W1T)), M, ODD_MAIN, DM}; pg8::StaticOrder S; S.init(M, ODD_MAIN, F.G, (int)blockIdx.x);
        pg8::EpiBf16S E{((u16*)(F.ws + WS_BIG)), ODD_MAIN, 4, 8, 0.088388347648318440f, (const float*)(F.ws + WS_SUMSQ)};
        pg8::gemm_phase<pg8::EpiBf16S, pg8::StaticOrder, true, PG8_SP2>(F.lds, g, S, E);
    }
    SEAM(6);
    if (IN(7)) REPS(7) { REPSYNC(); for (int u = blockIdx.x; u < 256; u += F.G) { const int dir = (u >> 1) & 1; mlstm_unit(F, u, dir ? ((u16*)(F.ws + WS_MIX)) : (u16*)F.out); } }
    SEAM(7);
    if (IN(8) && ((DUP_MASK) >> 8) & 1) { for (int m = F.gw; m < M; m += F.NGW) combine_token(F, m, (const u16*)F.out, ((u16*)(F.ws + WS_MIX)), ((u16*)(F.ws + WS_W0T)), (size_t)(16 * MiB - 1)); xcd_barrier(xbar); }
    if (IN(8)) { for (int m = F.gw; m < M; m += F.NGW) combine_token(F, m, (const u16*)F.out, ((u16*)(F.ws + WS_MIX)), ((u16*)(F.ws + WS_MIX)), ~(size_t)0); }
    SEAM(8);
    if (IN(9)) {
        pg8::Gemm g{((u16*)(F.ws + WS_MIX)), ((u16*)(F.ws + WS_WO1T)), M, DM, DM}; pg8::StaticOrder S; S.init(M, DM, F.G, (int)blockIdx.x);
        pg8::EpiResBf16G E{((u16*)(F.ws + WS_XN)), DM, F.norm_gain + DM, (float*)(F.ws + WS_SUMSQ) + M};
        pg8::gemm_phase<pg8::EpiResBf16G, pg8::StaticOrder, true, PG8_SP2>(F.lds, g, S, E);
    }
    SEAM(9);
    if (IN(10) && ((DUP_MASK) >> 10) & 1) { for (int m = F.gw; m < M; m += F.NGW) final_row(((u16*)(F.ws + WS_XN)) + (size_t)m * DM, ((const float*)(F.ws + WS_SUMSQ))[M + m], ((float*)(F.ws + WS_BIG)) + (size_t)m * DM, F.final_gain, F.lane); xcd_barrier(xbar); }
    if (IN(10)) { for (int m = F.gw; m < M; m += F.NGW) final_row(((u16*)(F.ws + WS_XN)) + (size_t)m * DM, ((const float*)(F.ws + WS_SUMSQ))[M + m], F.out + (size_t)m * DM, F.final_gain, F.lane); }
#undef IN
#undef SEAM
}

#ifndef MK_PER_PHASE
#define MK_PER_PHASE 0
#endif
extern "C" void kernel_launch(void* const* d_in, const int* in_sizes, int n_in, void* d_out, int out_size, void* d_ws, size_t ws_size, hipStream_t stream) {
    static int grid = 0;
    if (grid == 0) {
        if (n_in != 18 || in_sizes[0] != M * DM || out_size != M * DM || ws_size < WS_TOTAL) {
            fprintf(stderr, "kernel_launch: unexpected shapes: n_in %d in0 %d out %d ws %zu (need %zu)\n", n_in, n_in > 0 ? in_sizes[0] : -1, out_size, ws_size, (size_t)WS_TOTAL); grid = -1; return; }
        int dev = 0, cus = 0, per_cu = 0;
        if (hipGetDevice(&dev) != hipSuccess || hipDeviceGetAttribute(&cus, hipDeviceAttributeMultiprocessorCount, dev) != hipSuccess) { grid = -1; return; }
        if (hipFuncSetAttribute((const void*)fwd_megakernel, hipFuncAttributeMaxDynamicSharedMemorySize, LDS_BYTES) != hipSuccess) { fprintf(stderr, "kernel_launch: hipFuncSetAttribute failed\n"); grid = -1; return; }
        if (hipOccupancyMaxActiveBlocksPerMultiprocessor(&per_cu, (const void*)fwd_megakernel, NWAVES * 64, LDS_BYTES) != hipSuccess || per_cu < 1) { fprintf(stderr, "kernel_launch: occupancy query failed (%d)\n", per_cu); grid = -1; return; }
        grid = cus * per_cu;
    }
    if (grid < 0) return;
    if (hipMemsetAsync((char*)d_ws + WS_CTL, 0, CTL_BYTES, stream) != hipSuccess) { fprintf(stderr, "kernel_launch: memset failed\n"); return; }
    Args a{};
    for (int i = 0; i < 18; ++i) a.in[i] = (const float*)d_in[i];
    a.out = (float*)d_out; a.ws = (unsigned char*)d_ws;
#if MK_PER_PHASE
    for (int p = 0; p < NPHASES; ++p) { a.ph_lo = p; a.ph_hi = p + 1; void* kargs[] = {&a};
        hipError_t e = hipLaunchCooperativeKernel((void*)fwd_megakernel, dim3(grid), dim3(NWAVES * 64), kargs, LDS_BYTES, stream);
        if (e != hipSuccess) { fprintf(stderr, "kernel_launch: cooperative launch (phase %d) failed: %s (grid %d)\n", p, hipGetErrorString(e), grid); break; } }
#else
    a.ph_lo = 0; a.ph_hi = NPHASES; void* kargs[] = {&a};
    hipError_t e = hipLaunchCooperativeKernel((void*)fwd_megakernel, dim3(grid), dim3(NWAVES * 64), kargs, LDS_BYTES, stream);
    if (e != hipSuccess) fprintf(stderr, "kernel_launch: cooperative launch failed: %s (grid %d)\n", hipGetErrorString(e), grid);
#endif
}
```
